# Optimizing an MI355X kernel written in HIP

```python
import jax, jax.numpy as jnp
from jax import lax
import numpy as np

D_MODEL = 1024
BATCH = 8
SEQ = 2048
DEPTH = 4

GRID_W = 64
CTX_LEN = 256
N_MIXERS = 3
Q_BLOCK = 128
ROPE_THETA = 10000.0
EPS = 1e-6
N_MOD = 6
FFN_HIDDEN = -(-(8 * D_MODEL) // (3 * 256)) * 256
CONV_WIDTH = 3
GQA_HEAD_DIM = 128
GQA_HEADS = D_MODEL // GQA_HEAD_DIM
GQA_KV_HEADS = max(GQA_HEADS // 4, 1)
GQA_GROUP = GQA_HEADS // GQA_KV_HEADS
GQA_SCALE = GQA_HEAD_DIM ** -0.5
MLA_HEADS = D_MODEL // 128
MLA_NOPE = 128
MLA_ROPE = 64
MLA_V = 128
MLA_KV_RANK = D_MODEL // 4
MLA_Q_RANK = 3 * MLA_KV_RANK
MLA_SCALE = (MLA_NOPE + MLA_ROPE) ** -0.5
N_A = (DEPTH + 2) // 3
N_B = (DEPTH + 1) // 3
N_C = DEPTH // 3

kernel_name = 'hybrid_diffusion_backbone'


def rmsnorm(x, g):
    x32 = x.astype(jnp.float32)
    y = x32 * lax.rsqrt(jnp.mean(x32 * x32, axis=-1, keepdims=True) + EPS)
    return (y * g.astype(jnp.float32)).astype(x.dtype)


def modulation(cond_act, w, b):
    m = cond_act @ w + b
    return jnp.split(m[:, None, :], N_MOD, axis=-1)


def modulate(x, g, shift, scale):
    return rmsnorm(x, g) * (1 + scale) + shift


def swiglu(h, w1, w3, w2):
    return (jax.nn.silu(h @ w1) * (h @ w3)) @ w2


def axial_angles(rows, cols, rot_dim):
    n = rot_dim // 4
    freqs = ROPE_THETA ** (-jnp.arange(n, dtype=jnp.float32) / n)
    return jnp.concatenate([rows[:, None] * freqs, cols[:, None] * freqs], axis=-1)


def apply_rope(x, ang):
    half = ang.shape[-1]
    shape = (1, ang.shape[0]) + (1,) * (x.ndim - 3) + (half,)
    cos = jnp.cos(ang).reshape(shape)
    sin = jnp.sin(ang).reshape(shape)
    x32 = x.astype(jnp.float32)
    x1, x2 = x32[..., :half], x32[..., half:]
    return jnp.concatenate([x1 * cos - x2 * sin, x1 * sin + x2 * cos], axis=-1).astype(x.dtype)


def attend(q, k, v, scale):
    s = jnp.einsum('bqkgd,btkd->bkgqt', q, k, preferred_element_type=jnp.float32) * scale
    p = jax.nn.softmax(s, axis=-1).astype(v.dtype)
    return jnp.einsum('bkgqt,btkd->bqkgd', p, v)


def blocked_attend(q, k, v, scale):
    B, S = q.shape[0], q.shape[1]
    nb = S // Q_BLOCK
    qb = jnp.moveaxis(q.reshape((B, nb, Q_BLOCK) + q.shape[2:]), 1, 0)
    out = lax.map(lambda qq: attend(qq, k, v, scale), qb)
    out = jnp.moveaxis(out, 0, 1)
    return out.reshape((B, S) + out.shape[3:])


def short_conv_mixer(h, w_in, conv_w, w_out):
    S = h.shape[1]
    b_gate, c_gate, xv = jnp.split(h @ w_in, 3, axis=-1)
    pad = CONV_WIDTH // 2
    u = jnp.pad(c_gate * xv, ((0, 0), (pad, pad), (0, 0)))
    z = u[:, 0:S] * conv_w[0]
    for k in range(1, CONV_WIDTH):
        z = z + u[:, k:k + S] * conv_w[k]
    return (b_gate * z) @ w_out


def gqa_mixer(h_ctx, h_lat, wq, wk, wv, q_norm_g, k_norm_g, wo, ang, ctx_out):
    def proj(h):
        B, S, _ = h.shape
        q = (h @ wq).reshape(B, S, GQA_KV_HEADS, GQA_GROUP, GQA_HEAD_DIM)
        k = (h @ wk).reshape(B, S, GQA_KV_HEADS, GQA_HEAD_DIM)
        v = (h @ wv).reshape(B, S, GQA_KV_HEADS, GQA_HEAD_DIM)
        return rmsnorm(q, q_norm_g), rmsnorm(k, k_norm_g), v
    q_c, k_c, v_c = proj(h_ctx)
    q_l, k_l, v_l = proj(h_lat)
    q_l = apply_rope(q_l, ang)
    k_l = apply_rope(k_l, ang)
    k_all = jnp.concatenate([k_c, k_l], axis=1)
    v_all = jnp.concatenate([v_c, v_l], axis=1)
    B, S = h_lat.shape[0], h_lat.shape[1]
    y_l = blocked_attend(q_l, k_all, v_all, GQA_SCALE).reshape(B, S, GQA_HEADS * GQA_HEAD_DIM) @ wo
    y_c = None
    if ctx_out:
        L = h_ctx.shape[1]
        y_c = attend(q_c, k_c, v_c, GQA_SCALE).reshape(B, L, GQA_HEADS * GQA_HEAD_DIM) @ wo
    return y_c, y_l


def mla_project(h, w_dq, q_norm_g, w_uq, w_dkv, kv_norm_g, w_ukv, ang):
    B, S, _ = h.shape
    cq = rmsnorm(h @ w_dq, q_norm_g)
    q = (cq @ w_uq).reshape(B, S, MLA_HEADS, MLA_NOPE + MLA_ROPE)
    q_nope, q_pe = q[..., :MLA_NOPE], q[..., MLA_NOPE:]
    ckv_pe = h @ w_dkv
    ckv = rmsnorm(ckv_pe[..., :MLA_KV_RANK], kv_norm_g)
    k_pe = ckv_pe[..., None, MLA_KV_RANK:]
    kv = (ckv @ w_ukv).reshape(B, S, MLA_HEADS, MLA_NOPE + MLA_V)
    k_nope, v = kv[..., :MLA_NOPE], kv[..., MLA_NOPE:]
    if ang is not None:
        q_pe = apply_rope(q_pe, ang)
        k_pe = apply_rope(k_pe, ang)
    q = jnp.concatenate([q_nope, q_pe], axis=-1)[:, :, :, None, :]
    k = jnp.concatenate([k_nope, jnp.broadcast_to(k_pe, (B, S, MLA_HEADS, MLA_ROPE))], axis=-1)
    return q, k, v


def mla_mixer(h_ctx, h_lat, w_dq, q_norm_g, w_uq, w_dkv, kv_norm_g, w_ukv, wo, ang, ctx_out):
    q_c, k_c, v_c = mla_project(h_ctx, w_dq, q_norm_g, w_uq, w_dkv, kv_norm_g, w_ukv, None)
    q_l, k_l, v_l = mla_project(h_lat, w_dq, q_norm_g, w_uq, w_dkv, kv_norm_g, w_ukv, ang)
    k_all = jnp.concatenate([k_c, k_l], axis=1)
    v_all = jnp.concatenate([v_c, v_l], axis=1)
    B, S = h_lat.shape[0], h_lat.shape[1]
    y_l = blocked_attend(q_l, k_all, v_all, MLA_SCALE).reshape(B, S, MLA_HEADS * MLA_V) @ wo
    y_c = None
    if ctx_out:
        L = h_ctx.shape[1]
        y_c = attend(q_c, k_c, v_c, MLA_SCALE).reshape(B, L, MLA_HEADS * MLA_V) @ wo
    return y_c, y_l


def setup_inputs(seed: int = 0) -> dict:
    key = jax.random.key(seed)
    ks = iter(jax.random.split(key, 40))
    D = D_MODEL
    f32 = jnp.float32

    def w(shape, fan_in, mult=1.0):
        return jax.random.normal(next(ks), shape, f32) * (mult * fan_in ** -0.5)

    def gain(shape):
        return 1.0 + 0.02 * jax.random.normal(next(ks), shape, f32)

    return {
        'x': jax.random.normal(next(ks), (BATCH, SEQ, D), f32),
        'c': jax.random.normal(next(ks), (BATCH, D), f32),
        'ctx': jax.random.normal(next(ks), (BATCH, CTX_LEN, D), f32),
        'c_ctx': jax.random.normal(next(ks), (D,), f32),
        'ada_w': w((DEPTH, D, N_MOD * D), D, 0.5),
        'ada_b': 0.02 * jax.random.normal(next(ks), (DEPTH, N_MOD * D), f32),
        'norm1_g': gain((DEPTH, D)),
        'norm2_g': gain((DEPTH, D)),
        'ffn_w1': w((DEPTH, D, FFN_HIDDEN), D),
        'ffn_w3': w((DEPTH, D, FFN_HIDDEN), D),
        'ffn_w2': w((DEPTH, FFN_HIDDEN, D), FFN_HIDDEN),
        'conv_w_in': w((N_A, D, 3 * D), D),
        'conv_w': w((N_A, CONV_WIDTH, D), CONV_WIDTH),
        'conv_w_out': w((N_A, D, D), D),
        'gqa_wq': w((N_B, D, GQA_HEADS * GQA_HEAD_DIM), D),
        'gqa_wk': w((N_B, D, GQA_KV_HEADS * GQA_HEAD_DIM), D),
        'gqa_wv': w((N_B, D, GQA_KV_HEADS * GQA_HEAD_DIM), D),
        'gqa_q_norm': gain((N_B, GQA_HEAD_DIM)),
        'gqa_k_norm': gain((N_B, GQA_HEAD_DIM)),
        'gqa_wo': w((N_B, GQA_HEADS * GQA_HEAD_DIM, D), GQA_HEADS * GQA_HEAD_DIM),
        'mla_w_dq': w((N_C, D, MLA_Q_RANK), D),
        'mla_q_norm': gain((N_C, MLA_Q_RANK)),
        'mla_w_uq': w((N_C, MLA_Q_RANK, MLA_HEADS * (MLA_NOPE + MLA_ROPE)), MLA_Q_RANK),
        'mla_w_dkv': w((N_C, D, MLA_KV_RANK + MLA_ROPE), D),
        'mla_kv_norm': gain((N_C, MLA_KV_RANK)),
        'mla_w_ukv': w((N_C, MLA_KV_RANK, MLA_HEADS * (MLA_NOPE + MLA_V)), MLA_KV_RANK),
        'mla_wo': w((N_C, MLA_HEADS * MLA_V, D), MLA_HEADS * MLA_V),
        'final_g': gain((D,)),
    }


def reference(x, c, ctx, c_ctx, ada_w, ada_b, norm1_g, norm2_g, ffn_w1, ffn_w3, ffn_w2,
              conv_w_in, conv_w, conv_w_out,
              gqa_wq, gqa_wk, gqa_wv, gqa_q_norm, gqa_k_norm, gqa_wo,
              mla_w_dq, mla_q_norm, mla_w_uq, mla_w_dkv, mla_kv_norm, mla_w_ukv, mla_wo,
              final_g):
    S = x.shape[1]
    ROWS = S // GRID_W
    rows = jnp.repeat(jnp.arange(ROWS, dtype=jnp.float32), GRID_W)
    cols = jnp.tile(jnp.arange(GRID_W, dtype=jnp.float32), ROWS)
    ang_gqa = axial_angles(rows, cols, GQA_HEAD_DIM)
    ang_mla = axial_angles(rows, cols, MLA_ROPE)

    cond_lat = jax.nn.silu(c)
    cond_ctx = jax.nn.silu(c_ctx)[None]

    for i in range(DEPTH):
        kind = i % N_MIXERS
        j = i // N_MIXERS
        ctx_out = i < DEPTH - 1
        sh1, sc1, g1, sh2, sc2, g2 = modulation(cond_lat, ada_w[i], ada_b[i])
        csh1, csc1, cg1, csh2, csc2, cg2 = modulation(cond_ctx, ada_w[i], ada_b[i])

        h_lat = modulate(x, norm1_g[i], sh1, sc1)
        h_ctx = modulate(ctx, norm1_g[i], csh1, csc1) if (ctx_out or kind != 0) else None

        if kind == 0:
            y_lat = short_conv_mixer(h_lat, conv_w_in[j], conv_w[j], conv_w_out[j])
            y_ctx = short_conv_mixer(h_ctx, conv_w_in[j], conv_w[j], conv_w_out[j]) if ctx_out else None
        elif kind == 1:
            y_ctx, y_lat = gqa_mixer(h_ctx, h_lat, gqa_wq[j], gqa_wk[j], gqa_wv[j],
                                     gqa_q_norm[j], gqa_k_norm[j], gqa_wo[j], ang_gqa, ctx_out)
        else:
            y_ctx, y_lat = mla_mixer(h_ctx, h_lat, mla_w_dq[j], mla_q_norm[j], mla_w_uq[j],
                                     mla_w_dkv[j], mla_kv_norm[j], mla_w_ukv[j], mla_wo[j],
                                     ang_mla, ctx_out)

        x = x + g1 * y_lat
        x = x + g2 * swiglu(modulate(x, norm2_g[i], sh2, sc2), ffn_w1[i], ffn_w3[i], ffn_w2[i])
        if ctx_out:
            ctx = ctx + cg1 * y_ctx
            ctx = ctx + cg2 * swiglu(modulate(ctx, norm2_g[i], csh2, csc2), ffn_w1[i], ffn_w3[i], ffn_w2[i])

    return rmsnorm(x, final_g)
```

```cpp
#include <hip/hip_runtime.h>
#include <hip/hip_cooperative_groups.h>
#include <cstdio>
#include <cstdint>
namespace cg = cooperative_groups;

#define LAS __attribute__((address_space(3)))
typedef unsigned short bf16_t;
typedef short bf16x8 __attribute__((ext_vector_type(8)));
typedef short s16x4 __attribute__((ext_vector_type(4)));
typedef float f32x4 __attribute__((ext_vector_type(4)));
typedef float f32x16 __attribute__((ext_vector_type(16)));
typedef unsigned u32x4 __attribute__((ext_vector_type(4)));
typedef unsigned u32x2 __attribute__((ext_vector_type(2)));
#define DI __device__ __forceinline__

constexpr int NB = 8, SEQ = 2048, DM = 1024, CTXL = 256, RPB = SEQ + CTXL  , T = NB * RPB  ;
constexpr int FF = 2816, NMOD = 6 * DM;
constexpr float EPS = 1e-6f;
constexpr int NTHREADS = 512, NWAVES = 8;

constexpr size_t AL(size_t x) { return (x + 255) / 256 * 256; }
constexpr size_t WS_XC = 0;
constexpr size_t WS_MOD = WS_XC + AL((size_t)NB * CTXL * DM * 4);
constexpr size_t WS_RGC = WS_MOD + AL((size_t)4 * 9 * NMOD * 4);
constexpr size_t WS_RGS = WS_RGC + AL((size_t)SEQ * 64 * 4);
constexpr size_t WS_RMC = WS_RGS + AL((size_t)SEQ * 64 * 4);
constexpr size_t WS_RMS = WS_RMC + AL((size_t)SEQ * 32 * 4);
constexpr size_t WS_H = WS_RMS + AL((size_t)SEQ * 32 * 4);
constexpr size_t WS_BUF1 = WS_H + AL((size_t)T * DM * 2);
constexpr size_t WS_ACT = WS_BUF1 + AL((size_t)T * 2048 * 2);
constexpr size_t WS_CQ = WS_ACT + AL((size_t)T * FF * 2);
constexpr size_t WS_CKV = WS_CQ + AL((size_t)T * 768 * 2);
constexpr size_t WS_KPE = WS_CKV + AL((size_t)T * 256 * 2);
constexpr size_t WS_WUP = WS_KPE + AL((size_t)T * 64 * 2);
constexpr size_t SZ_WUP = (size_t)2 * FF * DM * 2;
constexpr size_t WS_WDN = WS_WUP + 4 * SZ_WUP;
constexpr size_t SZ_WDN = (size_t)DM * FF * 2;
constexpr size_t WS_WCI = WS_WDN + 4 * SZ_WDN;
constexpr size_t SZ_WCI = (size_t)3072 * DM * 2;
constexpr size_t WS_WCO = WS_WCI + 2 * SZ_WCI;
constexpr size_t SZ_WSQ = (size_t)DM * DM * 2;
constexpr size_t WS_WQKV = WS_WCO + 2 * SZ_WSQ;
constexpr size_t WS_WGO = WS_WQKV + (size_t)1536 * DM * 2;
constexpr size_t WS_WD = WS_WGO + SZ_WSQ;
constexpr size_t WS_WUQ = WS_WD + (size_t)1280 * DM * 2;
constexpr size_t WS_WUKV = WS_WUQ + (size_t)1536 * 768 * 2;
constexpr size_t WS_WMO = WS_WUKV + (size_t)2048 * 256 * 2;
constexpr size_t WS_SS = WS_WMO + SZ_WSQ;
constexpr size_t WS_SHWI = WS_SS + AL((size_t)10 * T * 4);
constexpr size_t WS_SHWU = WS_SHWI + AL((size_t)4 * 9 * 3072 * 4);
constexpr size_t WS_CTL = WS_SHWU + AL((size_t)4 * 9 * 5632 * 4);
constexpr size_t CTL_BYTES = 16384;
constexpr size_t WS_END = WS_CTL + CTL_BYTES;
static_assert((size_t)T * (1536 + 768 + 256) * 2 <= (size_t)T * FF * 2, "QM | CQ | CKV fit in the FFN hidden buffer");
constexpr size_t WS_XS = WS_CQ;
static_assert(WS_CKV == WS_CQ + (size_t)T * 768 * 2 && WS_KPE == WS_CKV + (size_t)T * 256 * 2, "CQ|CKV contiguous = XS");
static_assert(WS_END <= (size_t)400 * 1000 * 1000, "workspace budget");

constexpr int LDS_BYTES = 131072 + 4096 + 4096;

struct Params { const float* in[28]; float* out; unsigned char* ws; };

DI unsigned f2bf(float f) { unsigned u = __float_as_uint(f); return (u + 0x7fffu + ((u >> 16) & 1u)) >> 16; }
DI unsigned pk2(float lo, float hi) { return f2bf(lo) | (f2bf(hi) << 16); }
DI float bf2f(unsigned short b) { return __uint_as_float(((unsigned)b) << 16); }
DI float bflo(unsigned w) { return __uint_as_float(w << 16); }
DI float bfhi(unsigned w) { return __uint_as_float(w & 0xffff0000u); }
DI unsigned cvt_pk_bf16(float lo, float hi) { unsigned r; asm volatile("v_cvt_pk_bf16_f32 %0, %1, %2" : "=v"(r) : "v"(lo), "v"(hi)); return r; }
DI float wave_sum(float v) {
#pragma unroll
    for (int o = 1; o < 64; o <<= 1) v += __shfl_xor(v, o);
    return v;
}
DI int otid() { int t = threadIdx.x; asm volatile("" : "+v"(t)); return t; }
#define LDS_WAIT() asm volatile("s_waitcnt lgkmcnt(0)" ::: "memory")

namespace pg8 {
constexpr int BM = 256, BK = 64, HALF = 128, HTB = HALF * BK * 2, STAGE_BYTES = 8 * HTB, NXCD = 8, WGM = 8;
DI int lds_byte(int r, int c) { const int st = (r >> 4) * 2 + (c >> 5), rr = r & 15, cc = c & 31, ob = rr * 64 + cc * 2; return st * 1024 + (ob ^ (((ob >> 9) & 1) << 5)); }
DI void stage_rc(int b, int& R, int& C) { const int st = b / 1024, sb = b % 1024, swz = sb ^ (((sb >> 9) & 1) << 5); R = (st >> 1) * 16 + swz / 64; C = (st & 1) * 32 + (swz % 64) / 2; }
DI int perm32(int rho) { const int n = rho >> 4, i = rho & 15; return 8 * (i >> 2) + 4 * n + (i & 3); }

struct Unit { int pm, pn, k0, nt, part; };
struct Gemm { const bf16_t* A; const bf16_t* Bt; int lda, K; };

struct Sched {
    int nM, nN, nwg, G, c, latonly, ntk, skew, split;
    DI void init(int latonly_, int N, int G_, int c_, int K_ = DM, int skew_ = 0, int split_ = 0) { latonly = latonly_; nM = latonly_ ? 64 : 72; nN = N / BM; nwg = nM * nN; G = G_; c = c_; ntk = K_ / BK; skew = skew_; split = split_; }
    DI bool next(int i, Unit& u) const {
        long L = (long)i * G + c;
        if (split) {
            if (L >= 256 + 128) return false;
            if (L < 256) { int wgid = (int)L; { const int q = 256 / NXCD, xcd = wgid % NXCD, off = wgid / NXCD; wgid = xcd * q + off; }
                const int nig = WGM * 4, gid = wgid / nig, fm = gid * WGM; const int pm = fm + ((wgid % nig) % WGM); u.pn = (wgid % nig) / WGM;
                u.pm = (pm >> 3) * 9 + 1 + (pm & 7); u.k0 = 0; u.nt = ntk; u.part = 0; }
            else { const int idx = (int)L - 256, tile = idx >> 2, seg = idx & 3; u.pm = (tile >> 2) * 9; u.pn = tile & 3; u.part = 1 + seg;
                if (ntk == 44) { u.k0 = (seg >> 1) * 22 + (seg & 1) * 12; u.nt = (seg & 1) ? 10 : 12; } else { u.k0 = seg * 4; u.nt = 4; } }
            return true;
        }
        if (skew && G == 256) {
            if (c < 128) { if (i > 0) return false; L = c; } else L = c + 128 * i; }
        if (L >= nwg) return false;
        u.k0 = 0; u.nt = ntk; u.part = 0;
        int wgid = (int)L; { const int q = nwg / NXCD, r = nwg % NXCD, xcd = wgid % NXCD, off = wgid / NXCD; wgid = (xcd < r ? xcd * (q + 1) : r * (q + 1) + (xcd - r) * q) + off; }
        const int nig = WGM * nN, gid = wgid / nig, fm = gid * WGM, gsz = (nM - fm) < WGM ? (nM - fm) : WGM;
        int pm = fm + ((wgid % nig) % gsz); u.pn = (wgid % nig) / gsz;
        u.pm = latonly ? (pm >> 3) * 9 + 1 + (pm & 7) : pm; return true;
    }
    DI void a_ready(const Unit&) const {}
    DI void done(const Unit&) const {}
};

template <class Epi, class SchedT>
DI void gemm_phase(LAS unsigned char* lds, const Gemm g, const SchedT& S, const Epi& E) {
    const int tid = otid(), wid = __builtin_amdgcn_readfirstlane(tid >> 6), lane = tid & 63, wr = wid >> 2, wc = wid & 3, fr = lane & 15, fq = lane >> 4;
    const int K = g.K, lda = g.lda;
    unsigned voffA[2], voffB[2];
#pragma unroll
    for (int i = 0; i < 2; ++i) { int R, C; stage_rc(tid * 16 + i * 8192, R, C); const int Rb = Epi::PERM ? ((R & ~31) + perm32(R & 31)) : R;
        voffA[i] = (unsigned)(R * lda + C) * 2u; voffB[i] = (unsigned)(Rb * K + C) * 2u; }
    const size_t kstep = (size_t)(BK * 2);
    const size_t hstepA = (size_t)HALF * lda * 2, hstepB = (size_t)HALF * K * 2;
    const size_t tstepA = 2 * hstepA, tstepB = 2 * hstepB;
    const unsigned ldsw = (unsigned)wid * 1024u;
    const int aoff = lds_byte(wr * 64 + fr, fq * 8), boff = lds_byte(wc * 32 + fr, fq * 8);
#define PG8_SA(b, h) (((b) * 2 + (h)) * HTB)
#define PG8_SB(b, h) ((4 + (b) * 2 + (h)) * HTB)
#define PG8_STAGE(bufoff, gbase, voff) do { _Pragma("unroll") for (int _i = 0; _i < 2; ++_i) \
        __builtin_amdgcn_global_load_lds((const unsigned*)((const char*)(gbase) + (voff)[_i]), (LAS unsigned*)(lds + (bufoff) + ldsw + _i * 8192), 16, 0, 0); } while (0)
#define PG8_LDA(dst, b, h) do { _Pragma("unroll") for (int m = 0; m < 4; ++m) _Pragma("unroll") for (int k = 0; k < 2; ++k) dst[m][k] = *(const LAS bf16x8*)(lds + PG8_SA(b, h) + aoff + m * 2048 + k * 1024); } while (0)
#define PG8_LDB(dst, b, h) do { _Pragma("unroll") for (int n = 0; n < 2; ++n) _Pragma("unroll") for (int k = 0; k < 2; ++k) dst[n][k] = *(const LAS bf16x8*)(lds + PG8_SB(b, h) + boff + n * 2048 + k * 1024); } while (0)
#define PG8_MMA(ai, bj, At, Bt) do { __builtin_amdgcn_s_setprio(1); _Pragma("unroll") for (int m = 0; m < 4; ++m) _Pragma("unroll") for (int n = 0; n < 2; ++n) _Pragma("unroll") for (int k = 0; k < 2; ++k) \
        acc[ai][bj][m][n] = __builtin_amdgcn_mfma_f32_16x16x32_bf16(Bt[n][k], At[m][k], acc[ai][bj][m][n], 0, 0, 0); __builtin_amdgcn_s_setprio(0); } while (0)
#define PG8_WAIT_V(n) asm volatile("s_waitcnt vmcnt(" #n ")" ::: "memory")
#define PG8_WAIT_L(n) asm volatile("s_waitcnt lgkmcnt(" #n ")" ::: "memory")
#define PG8_BAR __builtin_amdgcn_s_barrier()
#define PG8_SCHED __builtin_amdgcn_sched_barrier(0)
    Unit cur, nxt; int ui = 0;
    if (!S.next(0, cur)) return;
    f32x4 acc[2][2][4][2];
#pragma unroll
    for (int a = 0; a < 2; ++a)
#pragma unroll
        for (int b = 0; b < 2; ++b)
#pragma unroll
            for (int m = 0; m < 4; ++m)
#pragma unroll
                for (int n = 0; n < 2; ++n) acc[a][b][m][n] = (f32x4){0.f, 0.f, 0.f, 0.f};
    bf16x8 At[4][2], B0[2][2], B1[2][2];
    const char* cA = (const char*)g.A + (size_t)cur.pm * tstepA + (size_t)cur.k0 * kstep; const char* cB = (const char*)g.Bt + (size_t)cur.pn * tstepB + (size_t)cur.k0 * kstep;
    S.a_ready(cur);
    PG8_STAGE(PG8_SB(0, 0), cB, voffB); PG8_STAGE(PG8_SB(0, 1), cB + hstepB, voffB); PG8_STAGE(PG8_SA(0, 0), cA, voffA); PG8_STAGE(PG8_SA(0, 1), cA + hstepA, voffA);
    if (wr == 1) PG8_BAR;
    PG8_WAIT_V(2); PG8_BAR;
    PG8_STAGE(PG8_SB(1, 0), cB + kstep, voffB); PG8_STAGE(PG8_SA(1, 0), cA + kstep, voffA); PG8_STAGE(PG8_SB(1, 1), cB + hstepB + kstep, voffB);
    PG8_WAIT_V(6); PG8_BAR;
    for (;;) {
        const bool has_next = S.next(ui + 1, nxt);
        const char* nA = has_next ? (const char*)g.A + (size_t)nxt.pm * tstepA + (size_t)nxt.k0 * kstep : cA; const char* nB = has_next ? (const char*)g.Bt + (size_t)nxt.pn * tstepB + (size_t)nxt.k0 * kstep : cB;
        const int nt = cur.nt;
        for (int t = 0; t < nt; t += 2) {
            const bool last = (t == nt - 2);
            const char* a1 = cA + (size_t)(t + 1) * kstep;
            const char* a2 = last ? nA : cA + (size_t)(t + 2) * kstep; const char* b2 = last ? nB : cB + (size_t)(t + 2) * kstep;
            const char* a3 = a2 + kstep; const char* b3 = b2 + kstep;
            if (last && has_next) S.a_ready(nxt);
            PG8_LDB(B0, 0, 0); PG8_LDB(B1, 0, 1); PG8_SCHED; PG8_LDA(At, 0, 0); PG8_STAGE(PG8_SA(1, 1), a1 + hstepA, voffA);
            PG8_WAIT_V(8); PG8_WAIT_L(0); PG8_BAR; PG8_MMA(0, 0, At, B0); PG8_MMA(0, 1, At, B1); PG8_BAR; PG8_SCHED;
            PG8_LDA(At, 0, 1); PG8_STAGE(PG8_SB(0, 0), b2, voffB); PG8_STAGE(PG8_SB(0, 1), b2 + hstepB, voffB); PG8_STAGE(PG8_SA(0, 0), a2, voffA);
            PG8_WAIT_V(8); PG8_WAIT_L(0); PG8_BAR; PG8_MMA(1, 0, At, B0); PG8_MMA(1, 1, At, B1); PG8_BAR; PG8_SCHED;
            PG8_LDB(B0, 1, 0); PG8_LDB(B1, 1, 1); PG8_SCHED; PG8_LDA(At, 1, 0); PG8_STAGE(PG8_SA(0, 1), a2 + hstepA, voffA);
            PG8_WAIT_V(8); PG8_WAIT_L(0); PG8_BAR; PG8_MMA(0, 0, At, B0); PG8_MMA(0, 1, At, B1); PG8_BAR; PG8_SCHED;
            PG8_LDA(At, 1, 1); PG8_STAGE(PG8_SB(1, 0), b3, voffB); PG8_STAGE(PG8_SB(1, 1), b3 + hstepB, voffB); PG8_STAGE(PG8_SA(1, 0), a3, voffA);
            PG8_WAIT_V(8); PG8_WAIT_L(0); PG8_BAR; PG8_MMA(1, 0, At, B0); PG8_MMA(1, 1, At, B1); PG8_BAR; PG8_SCHED;
        }
        if (wr == 0) PG8_BAR;
        E(acc, cur, wr, wc, fr, fq); S.done(cur);
        if (!has_next) break;
#pragma unroll
        for (int a = 0; a < 2; ++a)
#pragma unroll
            for (int b = 0; b < 2; ++b)
#pragma unroll
                for (int m = 0; m < 4; ++m)
#pragma unroll
                    for (int n = 0; n < 2; ++n) acc[a][b][m][n] = (f32x4){0.f, 0.f, 0.f, 0.f};
        cur = nxt; cA = nA; cB = nB; ++ui;
        if (wr == 1) PG8_BAR;
    }
    PG8_WAIT_V(0);
    PG8_BAR;
#undef PG8_SA
#undef PG8_SB
#undef PG8_STAGE
#undef PG8_LDA
#undef PG8_LDB
#undef PG8_MMA
#undef PG8_WAIT_V
#undef PG8_WAIT_L
#undef PG8_BAR
#undef PG8_SCHED
}

enum { EK_CONVIN = 0, EK_RESID = 1, EK_BF16 = 2, EK_SWIGLU = 3, EK_F32 = 4, EK_MLAQ = 5, EK_MLAD = 6, EK_QKV = 7 };
typedef f32x4 AccT[2][2][4][2];

template <int KIND> struct Epi {
    static constexpr bool PERM = (KIND != EK_RESID && KIND != EK_F32);
    bf16_t* O; int ldc;
    float* Cf;
    const float* srcL; const float* srcC; float* dstL; float* dstC; const float* gate;
    const float* cosT; const float* sinT;
    float inv_n;
    LAS unsigned char* xlds;
    float* slab;
    bf16_t* O2; bf16_t* O3; const float* g1; const float* g2; float* ssa; float* ssb;
    const float* ss; const float* shw; int shwN;
    const float* gnext; const float* scnext; float* ssnext; bf16_t* XS;

    DI void coefs(int mi, int row0, int colbase, int nstep, float (&rs)[2][4], f32x4 (&sw)[2][2]) const {
        const float in_ = inv_n > 0.f ? inv_n : (1.f / DM);
#pragma unroll
        for (int ai = 0; ai < 2; ++ai)
#pragma unroll
            for (int m = 0; m < 4; ++m) rs[ai][m] = ss ? 1.0f / sqrtf(ss[row0 + ai * HALF + m * 16] * in_ + EPS) : 1.f;
#pragma unroll
        for (int bj = 0; bj < 2; ++bj)
#pragma unroll
            for (int n = 0; n < 2; ++n) sw[bj][n] = shw ? *(const f32x4*)(shw + (size_t)mi * shwN + colbase + bj * HALF + n * nstep) : (f32x4){0.f, 0.f, 0.f, 0.f};
    }

    DI void operator()(const AccT& acc, const Unit& u, int wr, int wc, int fr, int fq) const {
        const int row0 = u.pm * BM + wr * 64 + fr;
        const int mi_ = (u.pm % 9 == 0) ? 8 : u.pm / 9;
        if constexpr (KIND == EK_RESID) {
            const int b = u.pm / 9, tq = u.pm - b * 9, mi = tq == 0 ? 8 : b;
            const size_t rowbase = tq == 0 ? (size_t)b * CTXL : (size_t)b * SEQ + (size_t)(tq - 1) * 256;
            const float* src = tq == 0 ? srcC : srcL; float* dst = tq == 0 ? dstC : dstL;
            const int col0 = u.pn * BM + wc * 32 + 4 * fq;
            if (u.part) {
                float* sp = slab + (size_t)((b * 4 + u.pn) * 4 + (u.part - 1)) * 65536 + (size_t)(wr * 64 + fr) * 256 + wc * 32 + 4 * fq;
#pragma unroll
                for (int ai = 0; ai < 2; ++ai)
#pragma unroll
                    for (int m = 0; m < 4; ++m)
#pragma unroll
                        for (int bj = 0; bj < 2; ++bj)
#pragma unroll
                            for (int n = 0; n < 2; ++n) *(f32x4*)(sp + (ai * HALF + m * 16) * 256 + bj * HALF + n * 16) = acc[ai][bj][m][n];
                return;
            }
            f32x4 gv[2][2], gsv[2][2]; const bool fuse = gnext != nullptr;
#pragma unroll
            for (int bj = 0; bj < 2; ++bj)
#pragma unroll
                for (int n = 0; n < 2; ++n) { gv[bj][n] = *(const f32x4*)(gate + (size_t)mi * NMOD + col0 + bj * HALF + n * 16);
                    if (fuse) { const f32x4 g4 = *(const f32x4*)(gnext + col0 + bj * HALF + n * 16), s4 = *(const f32x4*)(scnext + (size_t)mi * NMOD + col0 + bj * HALF + n * 16); gsv[bj][n] = g4 * (s4 + 1.0f); }
                    else gsv[bj][n] = (f32x4){0.f, 0.f, 0.f, 0.f}; }
            float sq[2][4];
#pragma unroll
            for (int ai = 0; ai < 2; ++ai)
#pragma unroll
                for (int mh = 0; mh < 2; ++mh) {
                    f32x4 xv[2][2][2];
#pragma unroll
                    for (int mm = 0; mm < 2; ++mm)
#pragma unroll
                        for (int bj = 0; bj < 2; ++bj)
#pragma unroll
                            for (int n = 0; n < 2; ++n) xv[mm][bj][n] = *(const f32x4*)(src + (rowbase + wr * 64 + fr + ai * HALF + (2 * mh + mm) * 16) * DM + col0 + bj * HALF + n * 16);
#pragma unroll
                    for (int mm = 0; mm < 2; ++mm) { const int m = 2 * mh + mm; const size_t off = (rowbase + wr * 64 + fr + ai * HALF + m * 16) * DM + col0; float sacc = 0.f;
                        bf16_t* xsp = XS + (size_t)(row0 + ai * HALF + m * 16) * DM + col0;
#pragma unroll
                        for (int bj = 0; bj < 2; ++bj)
#pragma unroll
                            for (int n = 0; n < 2; ++n) { const size_t o = off + bj * HALF + n * 16;
                                const f32x4 xn = xv[mm][bj][n] + gv[bj][n] * acc[ai][bj][m][n];
                                *(f32x4*)(dst + o) = xn;
                                if (fuse) { sacc += (xn.x * xn.x + xn.y * xn.y) + (xn.z * xn.z + xn.w * xn.w); const f32x4 xs = xn * gsv[bj][n];
                                    u32x2 w2; w2.x = cvt_pk_bf16(xs.x, xs.y); w2.y = cvt_pk_bf16(xs.z, xs.w); *(u32x2*)(xsp + bj * HALF + n * 16) = w2; } }
                        sq[ai][m] = sacc; }
                }
            if (fuse) {
#pragma unroll
                for (int ai = 0; ai < 2; ++ai)
#pragma unroll
                    for (int m = 0; m < 4; ++m) { float t = sq[ai][m]; t += __shfl_xor(t, 16); t += __shfl_xor(t, 32);
                        if (fq == 0) atomicAdd(ssnext + row0 + ai * HALF + m * 16, t); }
            }
        } else if constexpr (KIND == EK_F32) {
            const int col0 = u.pn * BM + wc * 32 + 4 * fq;
            float rs[2][4]; f32x4 sw[2][2]; coefs(mi_, row0, col0, 16, rs, sw);
#pragma unroll
            for (int ai = 0; ai < 2; ++ai)
#pragma unroll
                for (int m = 0; m < 4; ++m) { float* rowp = Cf + (size_t)(row0 + ai * HALF + m * 16) * ldc + col0;
#pragma unroll
                    for (int bj = 0; bj < 2; ++bj)
#pragma unroll
                        for (int n = 0; n < 2; ++n) *(f32x4*)(rowp + bj * HALF + n * 16) = acc[ai][bj][m][n] * rs[ai][m] + sw[bj][n]; }
        } else if constexpr (KIND == EK_BF16) {
            const int col0 = u.pn * BM + wc * 32 + 8 * fq;
            float rs[2][4]; f32x4 sw[2][2]; coefs(mi_, row0, col0, 4, rs, sw);
#pragma unroll
            for (int ai = 0; ai < 2; ++ai)
#pragma unroll
                for (int m = 0; m < 4; ++m) { bf16_t* rowp = O + (size_t)(row0 + ai * HALF + m * 16) * ldc + col0;
#pragma unroll
                    for (int bj = 0; bj < 2; ++bj) { const f32x4 v0 = acc[ai][bj][m][0] * rs[ai][m] + sw[bj][0], v1 = acc[ai][bj][m][1] * rs[ai][m] + sw[bj][1];
                        u32x4 w; w.x = cvt_pk_bf16(v0[0], v0[1]); w.y = cvt_pk_bf16(v0[2], v0[3]); w.z = cvt_pk_bf16(v1[0], v1[1]); w.w = cvt_pk_bf16(v1[2], v1[3]);
                        *(u32x4*)(rowp + bj * HALF) = w; } }
        } else if constexpr (KIND == EK_CONVIN) {
            float rs[2][4]; f32x4 sw[2][2]; coefs(mi_, row0, u.pn * BM + wc * 32 + 8 * fq, 4, rs, sw);
            if (u.pn < 4) {
                const int col0 = u.pn * BM + wc * 32 + 8 * fq;
#pragma unroll
                for (int ai = 0; ai < 2; ++ai)
#pragma unroll
                    for (int m = 0; m < 4; ++m) { bf16_t* rowp = O + (size_t)(row0 + ai * HALF + m * 16) * 2048 + col0;
#pragma unroll
                        for (int bj = 0; bj < 2; ++bj) { const f32x4 v0 = acc[ai][bj][m][0] * rs[ai][m] + sw[bj][0], v1 = acc[ai][bj][m][1] * rs[ai][m] + sw[bj][1];
                            u32x4 w; w.x = cvt_pk_bf16(v0[0], v0[1]); w.y = cvt_pk_bf16(v0[2], v0[3]); w.z = cvt_pk_bf16(v1[0], v1[1]); w.w = cvt_pk_bf16(v1[2], v1[3]);
                            *(u32x4*)(rowp + bj * HALF) = w; } }
            } else {
                const int col0 = 1024 + (u.pn - 4) * HALF + wc * 32 + 8 * fq;
#pragma unroll
                for (int ai = 0; ai < 2; ++ai)
#pragma unroll
                    for (int m = 0; m < 4; ++m) { bf16_t* rowp = O + (size_t)(row0 + ai * HALF + m * 16) * 2048 + col0;
                        const f32x4 v0 = (acc[ai][0][m][0] * rs[ai][m] + sw[0][0]) * (acc[ai][1][m][0] * rs[ai][m] + sw[1][0]);
                        const f32x4 v1 = (acc[ai][0][m][1] * rs[ai][m] + sw[0][1]) * (acc[ai][1][m][1] * rs[ai][m] + sw[1][1]);
                        u32x4 w; w.x = cvt_pk_bf16(v0[0], v0[1]); w.y = cvt_pk_bf16(v0[2], v0[3]); w.z = cvt_pk_bf16(v1[0], v1[1]); w.w = cvt_pk_bf16(v1[2], v1[3]);
                        *(u32x4*)rowp = w; }
            }
        } else if constexpr (KIND == EK_SWIGLU) {
            const int col0 = u.pn * HALF + wc * 32 + 8 * fq;
            float rs[2][4]; f32x4 sw[2][2]; coefs(mi_, row0, u.pn * BM + wc * 32 + 8 * fq, 4, rs, sw);
#pragma unroll
            for (int ai = 0; ai < 2; ++ai)
#pragma unroll
                for (int m = 0; m < 4; ++m) { bf16_t* rowp = O + (size_t)(row0 + ai * HALF + m * 16) * FF + col0;
                    f32x4 v[2];
#pragma unroll
                    for (int n = 0; n < 2; ++n) { const f32x4 a = acc[ai][0][m][n] * rs[ai][m] + sw[0][n], bb = acc[ai][1][m][n] * rs[ai][m] + sw[1][n];
                        const f32x4 t = a * (-1.4426950408889634f); f32x4 e;
                        e.x = __builtin_amdgcn_exp2f(t.x); e.y = __builtin_amdgcn_exp2f(t.y); e.z = __builtin_amdgcn_exp2f(t.z); e.w = __builtin_amdgcn_exp2f(t.w);
                        const f32x4 d = e + 1.0f; f32x4 r;
                        r.x = __builtin_amdgcn_rcpf(d.x); r.y = __builtin_amdgcn_rcpf(d.y); r.z = __builtin_amdgcn_rcpf(d.z); r.w = __builtin_amdgcn_rcpf(d.w);
                        v[n] = (a * bb) * r; }
                    u32x4 w; w.x = cvt_pk_bf16(v[0][0], v[0][1]); w.y = cvt_pk_bf16(v[0][2], v[0][3]); w.z = cvt_pk_bf16(v[1][0], v[1][1]); w.w = cvt_pk_bf16(v[1][2], v[1][3]);
                    *(u32x4*)rowp = w; }
        } else if constexpr (KIND == EK_QKV) {
            float rs[2][4]; f32x4 sw[2][2]; coefs(mi_, row0, u.pn * BM + wc * 32 + 8 * fq, 4, rs, sw);
            LAS float* xch = (LAS float*)xlds;
            const int wid8 = wr * 4 + wc;
            f32x4 v[2][4][2][2];
#pragma unroll
            for (int ai = 0; ai < 2; ++ai)
#pragma unroll
                for (int m = 0; m < 4; ++m) { float sacc = 0.f;
#pragma unroll
                    for (int bj = 0; bj < 2; ++bj)
#pragma unroll
                        for (int n = 0; n < 2; ++n) { const f32x4 t = acc[ai][bj][m][n] * rs[ai][m] + sw[bj][n]; v[ai][m][bj][n] = t; sacc += (t.x * t.x + t.y * t.y) + (t.z * t.z + t.w * t.w); }
                    sacc += __shfl_xor(sacc, 16); sacc += __shfl_xor(sacc, 32);
                    if (fq == 0) xch[wid8 * 128 + (ai * 4 + m) * 16 + fr] = sacc; }
            asm volatile("s_waitcnt lgkmcnt(0)" ::: "memory"); __builtin_amdgcn_s_barrier(); asm volatile("" ::: "memory");
            if (u.pn < 5) {
                const int hd = 2 * u.pn + (wc >> 1), dd = 32 * (wc & 1) + 8 * fq;
                const float* gg = (u.pn < 4 ? g1 : g2);
                f32x4 ga[2][2];
#pragma unroll
                for (int bj = 0; bj < 2; ++bj)
#pragma unroll
                    for (int n = 0; n < 2; ++n) ga[bj][n] = *(const f32x4*)(gg + bj * 64 + dd + 4 * n);
                const int tq = u.pm % 9; const bool lat = tq != 0;
#pragma unroll
                for (int ai = 0; ai < 2; ++ai)
#pragma unroll
                    for (int m = 0; m < 4; ++m) { const int slot = (ai * 4 + m) * 16 + fr, lrow = wr * 64 + fr + ai * HALF + m * 16;
                        const float tot = xch[wid8 * 128 + slot] + xch[(wid8 ^ 1) * 128 + slot];
                        const float rn = 1.0f / sqrtf(tot * (1.f / 128.f) + EPS);
                        bf16_t* rowp = O + (size_t)(u.pm * BM + lrow) * 1536 + hd * 128 + dd;
                        f32x4 o1[2], o2[2];
#pragma unroll
                        for (int n = 0; n < 2; ++n) { const f32x4 y1 = v[ai][m][0][n] * rn * ga[0][n], y2 = v[ai][m][1][n] * rn * ga[1][n];
                            if (lat) { const int pos = (tq - 1) * 256 + lrow; const f32x4 cv = *(const f32x4*)(cosT + pos * 64 + dd + 4 * n), sv = *(const f32x4*)(sinT + pos * 64 + dd + 4 * n);
                                o1[n] = y1 * cv - y2 * sv; o2[n] = y1 * sv + y2 * cv; }
                            else { o1[n] = y1; o2[n] = y2; } }
                        u32x4 w; w.x = cvt_pk_bf16(o1[0][0], o1[0][1]); w.y = cvt_pk_bf16(o1[0][2], o1[0][3]); w.z = cvt_pk_bf16(o1[1][0], o1[1][1]); w.w = cvt_pk_bf16(o1[1][2], o1[1][3]);
                        *(u32x4*)rowp = w;
                        w.x = cvt_pk_bf16(o2[0][0], o2[0][1]); w.y = cvt_pk_bf16(o2[0][2], o2[0][3]); w.z = cvt_pk_bf16(o2[1][0], o2[1][1]); w.w = cvt_pk_bf16(o2[1][2], o2[1][3]);
                        *(u32x4*)(rowp + 64) = w; }
            } else {
                const int col0 = u.pn * BM + wc * 32 + 8 * fq;
#pragma unroll
                for (int ai = 0; ai < 2; ++ai)
#pragma unroll
                    for (int m = 0; m < 4; ++m) { bf16_t* rowp = O + (size_t)(row0 + ai * HALF + m * 16) * 1536 + col0;
#pragma unroll
                        for (int bj = 0; bj < 2; ++bj) { const f32x4 v0 = v[ai][m][bj][0], v1 = v[ai][m][bj][1];
                            u32x4 w; w.x = cvt_pk_bf16(v0[0], v0[1]); w.y = cvt_pk_bf16(v0[2], v0[3]); w.z = cvt_pk_bf16(v1[0], v1[1]); w.w = cvt_pk_bf16(v1[2], v1[3]);
                            *(u32x4*)(rowp + bj * HALF) = w; } }
            }
            asm volatile("s_waitcnt lgkmcnt(0)" ::: "memory"); __builtin_amdgcn_s_barrier(); asm volatile("" ::: "memory");
        } else if constexpr (KIND == EK_MLAD) {
            float rs[2][4]; f32x4 sw[2][2]; coefs(mi_, row0, u.pn * BM + wc * 32 + 8 * fq, 4, rs, sw);
            if (u.pn < 4) {
                const bool isq = u.pn < 3;
                bf16_t* base = isq ? O : O2; const int ld = isq ? 768 : 256; const int cbase = (isq ? u.pn * BM : 0) + wc * 32 + 8 * fq;
                const float* gg = (isq ? g1 : g2) + cbase; float* ssp = isq ? ssa : ssb;
                f32x4 gvv[2][2];
#pragma unroll
                for (int bj = 0; bj < 2; ++bj)
#pragma unroll
                    for (int n = 0; n < 2; ++n) gvv[bj][n] = *(const f32x4*)(gg + bj * HALF + 4 * n);
#pragma unroll
                for (int ai = 0; ai < 2; ++ai)
#pragma unroll
                    for (int m = 0; m < 4; ++m) { const int row = row0 + ai * HALF + m * 16; float sacc = 0.f;
#pragma unroll
                        for (int bj = 0; bj < 2; ++bj) { const f32x4 v0 = acc[ai][bj][m][0] * rs[ai][m] + sw[bj][0], v1 = acc[ai][bj][m][1] * rs[ai][m] + sw[bj][1];
                            sacc += ((v0.x * v0.x + v0.y * v0.y) + (v0.z * v0.z + v0.w * v0.w)) + ((v1.x * v1.x + v1.y * v1.y) + (v1.z * v1.z + v1.w * v1.w));
                            const f32x4 o0 = v0 * gvv[bj][0], o1 = v1 * gvv[bj][1];
                            u32x4 w; w.x = cvt_pk_bf16(o0[0], o0[1]); w.y = cvt_pk_bf16(o0[2], o0[3]); w.z = cvt_pk_bf16(o1[0], o1[1]); w.w = cvt_pk_bf16(o1[2], o1[3]);
                            *(u32x4*)(base + (size_t)row * ld + cbase + bj * HALF) = w; }
                        sacc += __shfl_xor(sacc, 16); sacc += __shfl_xor(sacc, 32);
                        if (fq == 0) atomicAdd(ssp + row, sacc); }
            } else if (wc == 0) {
                const int tq = u.pm % 9; const bool lat = tq != 0;
#pragma unroll
                for (int ai = 0; ai < 2; ++ai)
#pragma unroll
                    for (int m = 0; m < 4; ++m) { const int lrow = wr * 64 + fr + ai * HALF + m * 16;
                        bf16_t* rowp = O3 + (size_t)(u.pm * BM + lrow) * 64 + 8 * fq;
                        f32x4 o1[2], o2[2];
#pragma unroll
                        for (int n = 0; n < 2; ++n) { const f32x4 x1 = acc[ai][0][m][n] * rs[ai][m] + sw[0][n], x2 = acc[ai][1][m][n] * rs[ai][m] + sw[1][n];
                            if (lat) { const int pos = (tq - 1) * 256 + lrow; const f32x4 cv = *(const f32x4*)(cosT + pos * 32 + 8 * fq + 4 * n), sv = *(const f32x4*)(sinT + pos * 32 + 8 * fq + 4 * n);
                                o1[n] = x1 * cv - x2 * sv; o2[n] = x1 * sv + x2 * cv; }
                            else { o1[n] = x1; o2[n] = x2; } }
                        u32x4 w; w.x = cvt_pk_bf16(o1[0][0], o1[0][1]); w.y = cvt_pk_bf16(o1[0][2], o1[0][3]); w.z = cvt_pk_bf16(o1[1][0], o1[1][1]); w.w = cvt_pk_bf16(o1[1][2], o1[1][3]);
                        *(u32x4*)rowp = w;
                        w.x = cvt_pk_bf16(o2[0][0], o2[0][1]); w.y = cvt_pk_bf16(o2[0][2], o2[0][3]); w.z = cvt_pk_bf16(o2[1][0], o2[1][1]); w.w = cvt_pk_bf16(o2[1][2], o2[1][3]);
                        *(u32x4*)(rowp + 32) = w; }
            }
        } else {
            float rs[2][4]; f32x4 sw[2][2]; coefs(mi_, row0, 0, 4, rs, sw);
            if (u.pn < 4) {
#pragma unroll
                for (int ai = 0; ai < 2; ++ai)
#pragma unroll
                    for (int m = 0; m < 4; ++m) { bf16_t* rowp = O + (size_t)(row0 + ai * HALF + m * 16) * 1536 + wc * 32 + 8 * fq;
#pragma unroll
                        for (int bj = 0; bj < 2; ++bj) { const f32x4 v0 = acc[ai][bj][m][0] * rs[ai][m], v1 = acc[ai][bj][m][1] * rs[ai][m];
                            u32x4 w; w.x = cvt_pk_bf16(v0[0], v0[1]); w.y = cvt_pk_bf16(v0[2], v0[3]); w.z = cvt_pk_bf16(v1[0], v1[1]); w.w = cvt_pk_bf16(v1[2], v1[3]);
                            *(u32x4*)(rowp + (2 * u.pn + bj) * 192) = w; } }
            } else {
                const int head = 4 * (u.pn - 4) + wc, j0 = 8 * fq;
                const int tq = u.pm % 9; const bool lat = tq != 0;
#pragma unroll
                for (int ai = 0; ai < 2; ++ai)
#pragma unroll
                    for (int m = 0; m < 4; ++m) { const int lrow = wr * 64 + fr + ai * HALF + m * 16;
                        bf16_t* rowp = O + (size_t)(u.pm * BM + lrow) * 1536 + head * 192 + 128 + j0;
                        f32x4 o1[2], o2[2];
                        if (lat) { const int pos = (tq - 1) * 256 + lrow;
#pragma unroll
                            for (int n = 0; n < 2; ++n) { const f32x4 cv = *(const f32x4*)(cosT + pos * 32 + j0 + 4 * n), sv = *(const f32x4*)(sinT + pos * 32 + j0 + 4 * n);
                                const f32x4 x1 = acc[ai][0][m][n] * rs[ai][m], x2 = acc[ai][1][m][n] * rs[ai][m]; o1[n] = x1 * cv - x2 * sv; o2[n] = x1 * sv + x2 * cv; }
                        } else { o1[0] = acc[ai][0][m][0] * rs[ai][m]; o1[1] = acc[ai][0][m][1] * rs[ai][m]; o2[0] = acc[ai][1][m][0] * rs[ai][m]; o2[1] = acc[ai][1][m][1] * rs[ai][m]; }
                        u32x4 w; w.x = cvt_pk_bf16(o1[0][0], o1[0][1]); w.y = cvt_pk_bf16(o1[0][2], o1[0][3]); w.z = cvt_pk_bf16(o1[1][0], o1[1][1]); w.w = cvt_pk_bf16(o1[1][2], o1[1][3]);
                        *(u32x4*)rowp = w;
                        w.x = cvt_pk_bf16(o2[0][0], o2[0][1]); w.y = cvt_pk_bf16(o2[0][2], o2[0][3]); w.z = cvt_pk_bf16(o2[1][0], o2[1][1]); w.w = cvt_pk_bf16(o2[1][2], o2[1][3]);
                        *(u32x4*)(rowp + 32) = w; }
            }
        }
    }
};
}

namespace att {
constexpr int NW = 8, QBLK = 32, KVBLK = 64;
constexpr float THR = 8.f;
constexpr int SHM_V = KVBLK * 128 * 2;
#define SBAR() __builtin_amdgcn_sched_barrier(0)
DI int crow(int r, int hi) { return (r & 3) + 8 * (r >> 2) + 4 * hi; }
DI unsigned cvtpk(float lo, float hi) { unsigned r; asm volatile("v_cvt_pk_bf16_f32 %0, %1, %2" : "=v"(r) : "v"(lo), "v"(hi)); return r; }
DI bf16x8 ld8(const bf16_t* p) { return *reinterpret_cast<const bf16x8*>(p); }

template <int DQK> struct Sc { static constexpr float SCALE = DQK == 128 ? 0.088388347648318440f : 0.072168783648703220f; };

template <int DQK>
DI void partialSM(f32x16& p0, f32x16& p1, float& m_reg, float& mn, float& alpha) {
  constexpr float SCALE = Sc<DQK>::SCALE;
  constexpr float C = SCALE * 1.4426950408889634f;
  float pmax = p0[0];
#pragma unroll
  for (int r = 1; r < 16; ++r) pmax = fmaxf(pmax, p0[r]);
#pragma unroll
  for (int r = 0; r < 16; ++r) pmax = fmaxf(pmax, p1[r]);
  { auto rr = __builtin_amdgcn_permlane32_swap(__float_as_uint(pmax), __float_as_uint(pmax), false, false);
    pmax = fmaxf(__uint_as_float(rr[0]), __uint_as_float(rr[1])); }
  if (__builtin_expect(__all(pmax - m_reg <= THR / SCALE), 1)) { mn = m_reg; alpha = 1.f; }
  else { mn = fmaxf(m_reg, pmax); alpha = __builtin_amdgcn_exp2f((m_reg - mn) * C); m_reg = mn; }
  float mnC = -mn * C;
#pragma unroll
  for (int r = 0; r < 16; ++r) p0[r] = fmaf(p0[r], C, mnC);
#pragma unroll
  for (int r = 0; r < 16; ++r) p1[r] = fmaf(p1[r], C, mnC);
#pragma unroll
  for (int r = 0; r < 16; ++r) p0[r] = __builtin_amdgcn_exp2f(p0[r]);
}
DI void finishSM(f32x16& p0, f32x16& p1, float alpha, float& l_reg, bf16x8& pa0, bf16x8& pa1, bf16x8& pa2, bf16x8& pa3) {
#pragma unroll
  for (int r = 0; r < 16; ++r) p1[r] = __builtin_amdgcn_exp2f(p1[r]);
  float ps = 0;
#pragma unroll
  for (int r = 0; r < 16; ++r) ps += p0[r];
#pragma unroll
  for (int r = 0; r < 16; ++r) ps += p1[r];
  { auto rr = __builtin_amdgcn_permlane32_swap(__float_as_uint(ps), __float_as_uint(ps), false, false);
    ps = __uint_as_float(rr[0]) + __uint_as_float(rr[1]); }
  l_reg = l_reg * alpha + ps;
#define PK4(P, BASE, OUT) do { unsigned a0 = cvtpk(P[BASE + 0], P[BASE + 1]), a1 = cvtpk(P[BASE + 2], P[BASE + 3]);   \
    unsigned b0 = cvtpk(P[BASE + 4], P[BASE + 5]), b1 = cvtpk(P[BASE + 6], P[BASE + 7]);                              \
    auto r0 = __builtin_amdgcn_permlane32_swap(a0, b0, false, false); auto r1 = __builtin_amdgcn_permlane32_swap(a1, b1, false, false); \
    u32x4 w = {r0[0], r1[0], r0[1], r1[1]}; OUT = *reinterpret_cast<bf16x8*>(&w); } while (0)
  PK4(p0, 0, pa0); PK4(p0, 8, pa1); PK4(p1, 0, pa2); PK4(p1, 8, pa3);
#undef PK4
}
#define KSWZ2(row, colB, RB) ((row) * (RB) + ((colB) ^ (((row) & 7) << 4)))
template <int DQK>
DI void qkt(f32x16& p0, f32x16& p1, const char* Ks, const bf16x8* qr, const char* qx, int r32, int hi) {
  constexpr int RB = DQK * 2;
  p0 = f32x16{}; p1 = f32x16{};
#pragma unroll
  for (int d0 = 0; d0 < DQK / 16; ++d0) { int cb = (d0 * 16 + hi * 8) * 2;
    bf16x8 b0 = *reinterpret_cast<const bf16x8*>(Ks + KSWZ2(r32, cb, RB));
    bf16x8 b1 = *reinterpret_cast<const bf16x8*>(Ks + KSWZ2(32 + r32, cb, RB));
    bf16x8 qf; if (d0 < 8) qf = qr[d0 < 8 ? d0 : 0]; else qf = *reinterpret_cast<const bf16x8*>(qx + (d0 - 8) * 1024);
    p0 = __builtin_amdgcn_mfma_f32_32x32x16_bf16(b0, qf, p0, 0, 0, 0);
    p1 = __builtin_amdgcn_mfma_f32_32x32x16_bf16(b1, qf, p1, 0, 0, 0); }
}
DI int v_st(int k, int c) { const int kk = (k & ~0xC) | ((k & 4) << 1) | ((k & 8) >> 1); return ((kk >> 3) * 4 + (c >> 5)) * 512 + ((kk & 7) * 32 + (c & 31)) * 2; }
DI int v_rd_base(int lane) { return ((lane & 3) << 3) | (((lane >> 2) & 3) << 6) | (((lane >> 4) & 1) << 5) | (((lane >> 5) & 1) << 8); }
constexpr int v_rd_off(int d0, int ks, int half) { return d0 * 512 + ks * 4096 + half * 2048; }
template <int OFF> DI s16x4 tr_read(int vb) {
  s16x4 r; asm volatile("ds_read_b64_tr_b16 %0, %1 offset:%2" : "=&v"(r) : "v"(vb), "i"(OFF) : "memory"); return r;
}
template <int D0> DI void pv_one(f32x16& od, int vb, bf16x8 pa0, bf16x8 pa1, bf16x8 pa2, bf16x8 pa3) {
  const s16x4 l0 = tr_read<v_rd_off(D0, 0, 0)>(vb), h0 = tr_read<v_rd_off(D0, 0, 1)>(vb), l1 = tr_read<v_rd_off(D0, 1, 0)>(vb), h1 = tr_read<v_rd_off(D0, 1, 1)>(vb);
  const s16x4 l2 = tr_read<v_rd_off(D0, 2, 0)>(vb), h2 = tr_read<v_rd_off(D0, 2, 1)>(vb), l3 = tr_read<v_rd_off(D0, 3, 0)>(vb), h3 = tr_read<v_rd_off(D0, 3, 1)>(vb);
  asm volatile("s_waitcnt lgkmcnt(0)" ::: "memory"); SBAR();
#define PK(L, H) (bf16x8){L[0], L[1], L[2], L[3], H[0], H[1], H[2], H[3]}
  od = __builtin_amdgcn_mfma_f32_32x32x16_bf16(pa0, PK(l0, h0), od, 0, 0, 0);
  od = __builtin_amdgcn_mfma_f32_32x32x16_bf16(pa1, PK(l1, h1), od, 0, 0, 0);
  od = __builtin_amdgcn_mfma_f32_32x32x16_bf16(pa2, PK(l2, h2), od, 0, 0, 0);
  od = __builtin_amdgcn_mfma_f32_32x32x16_bf16(pa3, PK(l3, h3), od, 0, 0, 0);
#undef PK
}
DI void pv_d0(f32x16* o, int vb, bf16x8 pa0, bf16x8 pa1, bf16x8 pa2, bf16x8 pa3) {
  pv_one<0>(o[0], vb, pa0, pa1, pa2, pa3); pv_one<1>(o[1], vb, pa0, pa1, pa2, pa3); pv_one<2>(o[2], vb, pa0, pa1, pa2, pa3); pv_one<3>(o[3], vb, pa0, pa1, pa2, pa3);
}

template <int DQK, int LDQ, int LDK, int SDEPTH>
DI void attn_body(const bf16_t* Qb, const bf16_t* Kh, const bf16_t* Vh, const bf16_t* Ph, bf16_t* Ob, int seq, char* lds) {
  constexpr int ND = DQK / 16, KRB = DQK * 2, SHM_K = KVBLK * KRB, LDO = 1024;
  const int tid = otid(), wid = tid >> 6, lane = tid & 63, r32 = lane & 31, hi = lane >> 5;
  char* V_lds = lds; char* K_lds = lds + 2 * SHM_V;
  float* ws = (float*)(lds + 2 * SHM_V + 2 * SHM_K) + wid * 64; float* li_l = ws; float* al_l = ws + 32;
  float m_reg = -1e30f, l_reg = 0; f32x16 o[4] = {}; bf16x8 qr[8];
  const bf16_t* Qw = Qb + (long)(wid * QBLK + r32) * LDQ + hi * 8;
#pragma unroll
  for (int d0 = 0; d0 < 8; ++d0) qr[d0] = __builtin_nontemporal_load(reinterpret_cast<const bf16x8*>(Qw + d0 * 16));
  char* qx = lds + 2 * SHM_V + 2 * SHM_K + NW * 256 + wid * 4096 + lane * 16;
  if constexpr (DQK == 192) {
#pragma unroll
    for (int d0 = 8; d0 < ND; ++d0) *reinterpret_cast<bf16x8*>(qx + (d0 - 8) * 1024) = ld8(Qw + d0 * 16);
    asm volatile("s_waitcnt lgkmcnt(0)" ::: "memory");
  }
  const int sr = tid >> 4, sc = (tid & 15) * 8, vst0 = v_st(sr, sc), vst1 = v_st(32 + sr, sc);
  const int pr = tid >> 3, pc = (tid & 7) * 8;
  const int vb0 = (int)(uintptr_t)V_lds + v_rd_base(lane);
  struct { bf16x8 vs0, vs1, ks0, ks1, ps; } sr_[SDEPTH];
#define SLOAD(i, k0) do { sr_[i].vs0 = ld8(&Vh[(long)((k0) + sr) * LDK + sc]); sr_[i].vs1 = ld8(&Vh[(long)((k0) + 32 + sr) * LDK + sc]); \
    sr_[i].ks0 = ld8(&Kh[(long)((k0) + sr) * LDK + sc]); sr_[i].ks1 = ld8(&Kh[(long)((k0) + 32 + sr) * LDK + sc]);                       \
    if constexpr (DQK == 192) sr_[i].ps = ld8(&Ph[(long)((k0) + pr) * 64 + pc]); } while (0)
#define SWRITE(b, i) do { *(bf16x8*)(V_lds + (b) * SHM_V + vst0) = sr_[i].vs0;          \
    *(bf16x8*)(V_lds + (b) * SHM_V + vst1) = sr_[i].vs1; int kc = sc * 2;               \
    *(bf16x8*)(K_lds + (b) * SHM_K + KSWZ2(sr, kc, KRB)) = sr_[i].ks0;                  \
    *(bf16x8*)(K_lds + (b) * SHM_K + KSWZ2(32 + sr, kc, KRB)) = sr_[i].ks1;             \
    if constexpr (DQK == 192) *(bf16x8*)(K_lds + (b) * SHM_K + KSWZ2(pr, 256 + pc * 2, KRB)) = sr_[i].ps; } while (0)
#define SWAIT() do { if constexpr (SDEPTH == 2) { if constexpr (DQK == 192) asm volatile("s_waitcnt vmcnt(5)" ::: "memory"); else asm volatile("s_waitcnt vmcnt(4)" ::: "memory"); } \
    else asm volatile("s_waitcnt vmcnt(0)" ::: "memory"); } while (0)
#define RESC(a) do { if (__any((a) < 1.f)) { if (hi == 0) al_l[r32] = (a); asm volatile("s_waitcnt lgkmcnt(0)" ::: "memory"); \
    _Pragma("unroll") for (int d = 0; d < 4; ++d) _Pragma("unroll") for (int r = 0; r < 16; ++r) o[d][r] *= al_l[crow(r, hi)]; } } while (0)
  f32x16 pA0, pA1, pB0, pB1; float mnA, mnB, alA, alB; bf16x8 pa0, pa1, pa2, pa3; const int NT = seq / KVBLK;
  constexpr int SE = 0, SO = SDEPTH - 1;
  SLOAD(SE, 0); asm volatile("s_waitcnt vmcnt(0)" ::: "memory"); SWRITE(0, SE); __syncthreads();
  qkt<DQK>(pA0, pA1, K_lds, qr, qx, r32, hi); partialSM<DQK>(pA0, pA1, m_reg, mnA, alA);
  SLOAD(SO, KVBLK); if constexpr (SDEPTH == 2) { if (2 < NT) SLOAD(SE, 2 * KVBLK); }
  SWAIT(); SWRITE(1, SO); __syncthreads();
  for (int j = 1; j + 1 < NT; j += 2) {
    SBAR(); qkt<DQK>(pB0, pB1, K_lds + SHM_K, qr, qx, r32, hi);
    finishSM(pA0, pA1, alA, l_reg, pa0, pa1, pa2, pa3); SBAR();
    SLOAD(SO, (j + SDEPTH) * KVBLK); SBAR();
    pv_d0(o, vb0, pa0, pa1, pa2, pa3); partialSM<DQK>(pB0, pB1, m_reg, mnB, alB);
    __syncthreads(); SWAIT(); SWRITE(0, SE);
    RESC(alB); __syncthreads();
    SBAR(); qkt<DQK>(pA0, pA1, K_lds, qr, qx, r32, hi);
    finishSM(pB0, pB1, alB, l_reg, pa0, pa1, pa2, pa3); SBAR();
    if (SDEPTH == 1 || j + 3 < NT) SLOAD(SE, (j + 1 + SDEPTH) * KVBLK); SBAR();
    pv_d0(o, vb0 + (int)SHM_V, pa0, pa1, pa2, pa3); partialSM<DQK>(pA0, pA1, m_reg, mnA, alA);
    __syncthreads(); SWAIT(); SWRITE(1, SO);
    RESC(alA); __syncthreads();
  }
  SBAR(); qkt<DQK>(pB0, pB1, K_lds + SHM_K, qr, qx, r32, hi);
  finishSM(pA0, pA1, alA, l_reg, pa0, pa1, pa2, pa3); SBAR();
  pv_d0(o, vb0, pa0, pa1, pa2, pa3); partialSM<DQK>(pB0, pB1, m_reg, mnB, alB);
  __syncthreads(); RESC(alB);
  finishSM(pB0, pB1, alB, l_reg, pa0, pa1, pa2, pa3); SBAR();
  pv_d0(o, vb0 + (int)SHM_V, pa0, pa1, pa2, pa3);
  if (hi == 0) li_l[r32] = l_reg; asm volatile("s_waitcnt lgkmcnt(0)" ::: "memory");
  float rli[16];
#pragma unroll
  for (int r = 0; r < 16; ++r) rli[r] = __builtin_amdgcn_rcpf(li_l[crow(r, hi)]);
  bf16_t* Ow = Ob + (long)(wid * QBLK) * LDO;
#pragma unroll
  for (int r = 0; r < 16; ++r) { int orow = crow(r, hi);
#pragma unroll
    for (int d0 = 0; d0 < 4; ++d0) Ow[(long)orow * LDO + d0 * 32 + r32] = (bf16_t)f2bf(o[d0][r] * rli[r]); }
#undef SLOAD
#undef SWRITE
#undef SWAIT
#undef RESC
}
}

DI int wrow(int mode, int p0, int n) {
    if (mode == 0) return p0 + n;
    if (mode == 1) { if (n < 1024) return n; const int s = (n - 1024) >> 10, ch = (n - 1024) & 1023; return 1024 + ((ch >> 7) << 8) + (s << 7) + (ch & 127); }
    if (mode == 2) return ((n >> 7) << 8) + (p0 << 7) + (n & 127);
    if (mode == 5) { const int hd = n >> 7, d = n & 127; return p0 + ((hd >> 1) << 8) + ((d >> 6) << 7) + ((hd & 1) << 6) + (d & 63); }
    if (mode == 4) { if (n < 256) return 768 + n; const int j = n - 256; return 1024 + ((j >> 5) << 7) + (j & 31); }
    const int h = n / 192, d = n - h * 192;
    if (d < 128) return ((h >> 1) << 8) + ((h & 1) << 7) + d;
    const int j = d - 128; return 1024 + ((h >> 2) << 8) + ((j >> 5) << 7) + ((h & 3) << 5) + (j & 31);
}
DI void transpose_item(const float* W, int K, int N, bf16_t* WT, int mode, int p0, LAS float* scr, int item, int lane) {
    const int nblk = N / 32, kb = item / nblk, nb = item - kb * nblk, k0 = 64 * kb, n0 = 32 * nb;
#pragma unroll
    for (int i = 0; i < 32; ++i) { const int kk = 2 * i + (lane >> 5); scr[kk * 33 + (lane & 31)] = __builtin_nontemporal_load(W + (size_t)(k0 + kk) * N + n0 + (lane & 31)); }
    LDS_WAIT(); asm volatile("" ::: "memory");
    const int c = lane & 7;
#pragma unroll
    for (int j = 0; j < 4; ++j) { const int n = (lane >> 3) + 8 * j; const LAS float* s = scr + (8 * c) * 33 + n;
        u32x4 o; o.x = pk2(s[0 * 33], s[1 * 33]); o.y = pk2(s[2 * 33], s[3 * 33]); o.z = pk2(s[4 * 33], s[5 * 33]); o.w = pk2(s[6 * 33], s[7 * 33]);
        *(u32x4*)(WT + (size_t)wrow(mode, p0, n0 + n) * K + k0 + 8 * c) = o; }
    LDS_WAIT(); asm volatile("" ::: "memory");
}

DI void transposes_items(const Params& P, LAS unsigned char* lds, int first, int last, int slot, int nslots, int deferred, int lane) {
    unsigned char* ws = P.ws; const int wave = otid() >> 6;
    LAS float* scr = (LAS float*)(lds + 61440 + wave * 8448);
    constexpr int I_FF = 1408, I_L = 3 * I_FF, I_CI = 1536, I_CO = 512, I_CV = I_CI + I_CO;
    constexpr int N0 = 4 * I_L, N1 = N0 + 2 * I_CV, N2 = N1 + 512 + 128 + 128 + 512, N3 = N2 + 384 + 160 + 576 + 256 + 512;
    static_assert(N3 - N0 - I_CV + 3 * I_L == 17888 && I_L + I_CV == 6272, "item counts");
    for (int d = first + slot; d < last; d += nslots) {
        int it;
        if (!deferred) it = d < I_L ? d : N0 + (d - I_L);
        else it = d < 3 * I_L ? I_L + d : N0 + I_CV + (d - 3 * I_L);
        const float* W; int K, N, mode = 0, p0 = 0, item; bf16_t* WT;
        if (it < N0) { const int l = it / I_L, q = it - l * I_L, wh = q / I_FF; item = q - wh * I_FF;
            if (wh == 0) { W = P.in[8] + (size_t)l * DM * FF; K = DM; N = FF; WT = (bf16_t*)(ws + WS_WUP + l * SZ_WUP); mode = 2; p0 = 0; }
            else if (wh == 1) { W = P.in[9] + (size_t)l * DM * FF; K = DM; N = FF; WT = (bf16_t*)(ws + WS_WUP + l * SZ_WUP); mode = 2; p0 = 1; }
            else { W = P.in[10] + (size_t)l * FF * DM; K = FF; N = DM; WT = (bf16_t*)(ws + WS_WDN + l * SZ_WDN); } }
        else if (it < N1) { const int r = it - N0, j = r / I_CV, q = r - j * I_CV;
            if (q < I_CI) { item = q; W = P.in[11] + (size_t)j * DM * 3072; K = DM; N = 3072; WT = (bf16_t*)(ws + WS_WCI + j * SZ_WCI); mode = 1; }
            else { item = q - I_CI; W = P.in[13] + (size_t)j * DM * DM; K = DM; N = DM; WT = (bf16_t*)(ws + WS_WCO + j * SZ_WSQ); } }
        else if (it < N2) { int r = it - N1;
            if (r < 512) { item = r; W = P.in[14]; K = DM; N = DM; WT = (bf16_t*)(ws + WS_WQKV); mode = 5; p0 = 0; }
            else if (r < 640) { item = r - 512; W = P.in[15]; K = DM; N = 256; WT = (bf16_t*)(ws + WS_WQKV); mode = 5; p0 = 1024; }
            else if (r < 768) { item = r - 640; W = P.in[16]; K = DM; N = 256; WT = (bf16_t*)(ws + WS_WQKV); p0 = 1280; }
            else { item = r - 768; W = P.in[19]; K = DM; N = DM; WT = (bf16_t*)(ws + WS_WGO); } }
        else { int r = it - N2;
            if (r < 384) { item = r; W = P.in[20]; K = DM; N = 768; WT = (bf16_t*)(ws + WS_WD); p0 = 0; }
            else if (r < 544) { item = r - 384; W = P.in[23]; K = DM; N = 320; WT = (bf16_t*)(ws + WS_WD); mode = 4; }
            else if (r < 1120) { item = r - 544; W = P.in[22]; K = 768; N = 1536; WT = (bf16_t*)(ws + WS_WUQ); mode = 3; }
            else if (r < 1376) { item = r - 1120; W = P.in[25]; K = 256; N = 2048; WT = (bf16_t*)(ws + WS_WUKV); }
            else { item = r - 1376; W = P.in[26]; K = DM; N = DM; WT = (bf16_t*)(ws + WS_WMO); } }
        transpose_item(W, K, N, WT, mode, p0, scr, item, lane);
    }
}

DI void prologue_phase(const Params& P, LAS unsigned char* lds, int G) {
    const int tid = otid(), lane = tid & 63, wave = tid >> 6;
    unsigned char* ws = P.ws;
    {
        LAS float* sc = (LAS float*)lds; LAS float* red = sc + 9 * DM;
        for (int i = tid; i < 9 * DM; i += NTHREADS) { const int r = i >> 10, k = i & 1023; const float v = r < 8 ? P.in[1][r * DM + k] : P.in[3][k]; sc[i] = v / (1.f + __expf(-v)); }
        __syncthreads();
        float* MOD = (float*)(ws + WS_MOD);
        for (int item = blockIdx.x; item < 4 * 48; item += G) {
            const int l = item / 48, n0 = (item - l * 48) * 128, ks = tid >> 5, cq = tid & 31;
            const float* Wp = P.in[4] + ((size_t)l * DM + ks * 64) * NMOD + n0 + 4 * cq;
            f32x4 a[9];
#pragma unroll
            for (int r = 0; r < 9; ++r) a[r] = (f32x4){0.f, 0.f, 0.f, 0.f};
            const LAS float* s = sc + ks * 64;
#pragma unroll 2
            for (int k4 = 0; k4 < 64; k4 += 4) {
                f32x4 w[4];
#pragma unroll
                for (int q = 0; q < 4; ++q) w[q] = __builtin_nontemporal_load((const f32x4*)(Wp + (size_t)(k4 + q) * NMOD));
#pragma unroll
                for (int r = 0; r < 9; ++r) { const f32x4 sv = *(const LAS f32x4*)(s + r * DM + k4);
                    a[r] += w[0] * sv.x; a[r] += w[1] * sv.y; a[r] += w[2] * sv.z; a[r] += w[3] * sv.w; } }
#pragma unroll
            for (int r = 0; r < 9; ++r) *(LAS f32x4*)(red + (ks * 9 + r) * 128 + 4 * cq) = a[r];
            __syncthreads();
            for (int o = tid; o < 9 * 128; o += NTHREADS) { const int r = o >> 7, c2 = o & 127; float sum = 0.f;
#pragma unroll
                for (int q = 0; q < 16; ++q) sum += red[(q * 9 + r) * 128 + c2];
                MOD[((size_t)l * 9 + r) * NMOD + n0 + c2] = sum + P.in[5][l * NMOD + n0 + c2]; }
            __syncthreads();
        }
    }
    {
        float* gc = (float*)(ws + WS_RGC); float* gs = (float*)(ws + WS_RGS); float* mc = (float*)(ws + WS_RMC); float* ms = (float*)(ws + WS_RMS);
        const int gt = blockIdx.x * NTHREADS + tid, NT_ = G * NTHREADS;
        for (int i = gt; i < SEQ * 96; i += NT_) {
            const int pos = i / 96, a = i - pos * 96; const float row = (float)(pos >> 6), col = (float)(pos & 63);
            if (a < 64) { const int fi = a & 31; const float fr = powf(10000.f, -(float)fi / 32.f); const float ang = (a < 32 ? row : col) * fr;
                gc[pos * 64 + a] = cosf(ang); gs[pos * 64 + a] = sinf(ang); }
            else { const int a2 = a - 64, fi = a2 & 15; const float fr = powf(10000.f, -(float)fi / 16.f); const float ang = (a2 < 16 ? row : col) * fr;
                mc[pos * 32 + a2] = cosf(ang); ms[pos * 32 + a2] = sinf(ang); }
        }
        { u32x4* zs = (u32x4*)(ws + WS_SS); for (int i = gt; i < 10 * T / 4; i += NT_) zs[i] = (u32x4){0u, 0u, 0u, 0u}; }
        { u32x4* z1 = (u32x4*)(ws + WS_WD + (size_t)1056 * DM * 2); u32x4* z2 = (u32x4*)(ws + WS_WD + (size_t)1184 * DM * 2);
          for (int i = gt; i < 96 * DM * 2 / 16; i += NT_) { z1[i] = (u32x4){0u, 0u, 0u, 0u}; z2[i] = (u32x4){0u, 0u, 0u, 0u}; } }
    }
    transposes_items(P, lds, 0, 6272, blockIdx.x * NWAVES + wave, G * NWAVES, 0, lane);
    transposes_items(P, lds, 0, 17888, blockIdx.x * NWAVES + wave, G * NWAVES, 1, lane);
}

DI void prenorm_phase(const float* XL, const float* XC, const float* g, const float* scv, bf16_t* XS, float* SS, int G) {
    const int tid = otid(), lane = tid & 63, gw = blockIdx.x * NWAVES + (tid >> 6), NGW = G * NWAVES;
    for (int r0 = gw; r0 < T; r0 += 3 * NGW) {
        const float* xr[3]; int mi[3], rr[3]; bool ok[3];
#pragma unroll
        for (int q = 0; q < 3; ++q) { const int r = r0 + q * NGW; ok[q] = r < T; rr[q] = ok[q] ? r : r0;
            const int b = rr[q] / RPB, w = rr[q] - b * RPB;
            if (w < CTXL) { xr[q] = XC + (size_t)(b * CTXL + w) * DM; mi[q] = 8; } else { xr[q] = XL + (size_t)(b * SEQ + w - CTXL) * DM; mi[q] = b; } }
        f32x4 v[3][4]; float ss[3];
#pragma unroll
        for (int q = 0; q < 3; ++q)
#pragma unroll
            for (int j = 0; j < 4; ++j) v[q][j] = ((const f32x4*)xr[q])[lane + 64 * j];
#pragma unroll
        for (int q = 0; q < 3; ++q) { float a = 0.f;
#pragma unroll
            for (int j = 0; j < 4; ++j) a += (v[q][j].x * v[q][j].x + v[q][j].y * v[q][j].y) + (v[q][j].z * v[q][j].z + v[q][j].w * v[q][j].w);
            ss[q] = a; }
#pragma unroll
        for (int o = 1; o < 64; o <<= 1)
#pragma unroll
            for (int q = 0; q < 3; ++q) ss[q] += __shfl_xor(ss[q], o);
#pragma unroll
        for (int q = 0; q < 3; ++q) if (ok[q]) {
            if (lane == 0) SS[rr[q]] = ss[q];
#pragma unroll
            for (int j = 0; j < 4; ++j) { const int col = 4 * (lane + 64 * j);
                const f32x4 gv = *(const f32x4*)(g + col), sc = *(const f32x4*)(scv + (size_t)mi[q] * NMOD + col);
                const f32x4 o = v[q][j] * gv * (sc + 1.0f);
                u32x2 w2; w2.x = pk2(o.x, o.y); w2.y = pk2(o.z, o.w);
                *(u32x2*)(XS + (size_t)rr[q] * DM + col) = w2; } }
    }
}
DI void ctxfix_phase(const float* XCsrc, float* XC, const float* slab, const float* gate, const float* g, const float* scv, bf16_t* XS, float* SS, int G) {
    const int tid = otid(), lane = tid & 63, gw = blockIdx.x * NWAVES + (tid >> 6), NGW = G * NWAVES;
    for (int rc = gw; rc < NB * CTXL; rc += NGW) {
        const int b = rc >> 8, w = rc & 255, r = b * RPB + w; float* xr = XC + (size_t)rc * DM; const float* xs_ = XCsrc + (size_t)rc * DM;
        f32x4 v[4]; float ss = 0.f;
#pragma unroll
        for (int j = 0; j < 4; ++j) {
            const float* sp = slab + (size_t)((b * 4 + j) * 4) * 65536 + (size_t)w * 256 + 4 * lane;
            const f32x4 p0 = *(const f32x4*)sp, p1 = *(const f32x4*)(sp + 65536), p2 = *(const f32x4*)(sp + 2 * 65536), p3 = *(const f32x4*)(sp + 3 * 65536);
            const f32x4 x0 = ((const f32x4*)xs_)[lane + 64 * j], gt4 = *(const f32x4*)(gate + (size_t)8 * NMOD + 4 * (lane + 64 * j));
            v[j] = x0 + gt4 * ((p0 + p1) + (p2 + p3));
            ss += (v[j].x * v[j].x + v[j].y * v[j].y) + (v[j].z * v[j].z + v[j].w * v[j].w); }
        ss = wave_sum(ss); if (lane == 0) SS[r] = ss;
#pragma unroll
        for (int j = 0; j < 4; ++j) { const int col = 4 * (lane + 64 * j);
            ((f32x4*)xr)[lane + 64 * j] = v[j];
            const f32x4 gv = *(const f32x4*)(g + col), sc = *(const f32x4*)(scv + (size_t)8 * NMOD + col);
            const f32x4 o = v[j] * gv * (sc + 1.0f);
            u32x2 w2; w2.x = pk2(o.x, o.y); w2.y = pk2(o.z, o.w);
            *(u32x2*)(XS + (size_t)r * DM + col) = w2; }
    }
}
DI void shw_phase(unsigned char* ws, LAS unsigned char* lds, int first, int stride, int set, int lo, int hi) {
    const int tid = otid(), lane = tid & 63, w = tid >> 6;
    const float* MOD = (const float*)(ws + WS_MOD);
    LAS float* shl = (LAS float*)lds; LAS float* red = shl + 9 * DM;
    int cur = -1;
    for (int it = lo + first; it < hi; it += stride) {
        const bf16_t* Wt; const float* sh; float* out; int N, c, cid;
        if (!set) {
            if (it < 48) { cid = 0; c = it; Wt = (const bf16_t*)(ws + WS_WCI); sh = MOD; out = (float*)(ws + WS_SHWI); N = 3072; }
            else { cid = 4; c = it - 48; Wt = (const bf16_t*)(ws + WS_WUP); sh = MOD + 3 * DM; out = (float*)(ws + WS_SHWU); N = 5632; }
        } else {
            if (it < 24) { cid = 1; c = it; Wt = (const bf16_t*)(ws + WS_WQKV); sh = MOD + (size_t)1 * 9 * NMOD; out = (float*)(ws + WS_SHWI) + 1 * 9 * 3072; N = 1536; }
            else if (it < 44) { cid = 2; c = it - 24; Wt = (const bf16_t*)(ws + WS_WD); sh = MOD + (size_t)2 * 9 * NMOD; out = (float*)(ws + WS_SHWI) + 2 * 9 * 3072; N = 1280; }
            else if (it < 92) { cid = 3; c = it - 44; Wt = (const bf16_t*)(ws + WS_WCI + SZ_WCI); sh = MOD + (size_t)3 * 9 * NMOD; out = (float*)(ws + WS_SHWI) + 3 * 9 * 3072; N = 3072; }
            else { const int q = it - 92, l = 1 + q / 88; cid = 4 + l; c = q - (l - 1) * 88; Wt = (const bf16_t*)(ws + WS_WUP + l * SZ_WUP); sh = MOD + (size_t)l * 9 * NMOD + 3 * DM; out = (float*)(ws + WS_SHWU) + (size_t)l * 9 * 5632; N = 5632; }
        }
        if (cid != cur) { __syncthreads(); for (int i = tid; i < 9 * DM; i += NTHREADS) shl[i] = sh[(size_t)(i >> 10) * NMOD + (i & 1023)]; cur = cid; __syncthreads(); }
        const u32x4* wp = (const u32x4*)(Wt + (size_t)(c * 64 + lane) * DM + 128 * w);
        float a[9];
#pragma unroll
        for (int mi = 0; mi < 9; ++mi) a[mi] = 0.f;
#pragma unroll 4
        for (int ch = 0; ch < 16; ++ch) { const u32x4 wv = wp[ch];
            const float e0 = bflo(wv.x), e1 = bfhi(wv.x), e2 = bflo(wv.y), e3 = bfhi(wv.y), e4 = bflo(wv.z), e5 = bfhi(wv.z), e6 = bflo(wv.w), e7 = bfhi(wv.w);
#pragma unroll
            for (int mi = 0; mi < 9; ++mi) { const LAS f32x4* sp = (const LAS f32x4*)(shl + mi * DM + 128 * w + 8 * ch); const f32x4 s0 = sp[0], s1 = sp[1];
                a[mi] += (s0.x * e0 + s0.y * e1) + (s0.z * e2 + s0.w * e3) + (s1.x * e4 + s1.y * e5) + (s1.z * e6 + s1.w * e7); } }
#pragma unroll
        for (int mi = 0; mi < 9; ++mi) red[(w * 9 + mi) * 64 + lane] = a[mi];
        __syncthreads();
        for (int o = tid; o < 9 * 64; o += NTHREADS) { const int mi = o >> 6, c2 = o & 63; float sum = 0.f;
#pragma unroll
            for (int q = 0; q < 8; ++q) sum += red[(q * 9 + mi) * 64 + c2];
            out[(size_t)mi * N + c * 64 + c2] = sum; }
        __syncthreads();
    }
}

DI void conv_phase(const bf16_t* __restrict__ BUF1, const float* __restrict__ cw, bf16_t* __restrict__ H, bool latonly, int G) {
    const int gt = blockIdx.x * NTHREADS + otid(), NT_ = G * NTHREADS;
    if ((NT_ & 127) == 0) {
        const int c8 = (gt & 127) * 8, rstep = NT_ >> 7;
        float w0[8], w1[8], w2[8];
#pragma unroll
        for (int q = 0; q < 8; ++q) { w0[q] = cw[c8 + q]; w1[q] = cw[DM + c8 + q]; w2[q] = cw[2 * DM + c8 + q]; }
#pragma unroll 3
        for (int r = gt >> 7; r < T; r += rstep) {
            const int b = r / RPB, w = r - b * RPB;
            if (latonly && w < CTXL) continue;
            const bool hp = !(w == 0 || w == CTXL), hn = !(w == CTXL - 1 || w == RPB - 1);
            const bf16_t* up = BUF1 + (size_t)r * 2048 + 1024 + c8;
            const u32x4 zero = {0u, 0u, 0u, 0u};
            const u32x4 uc = *(const u32x4*)up, um = hp ? *(const u32x4*)(up - 2048) : zero, un = hn ? *(const u32x4*)(up + 2048) : zero;
            const u32x4 bb = __builtin_nontemporal_load((const u32x4*)(BUF1 + (size_t)r * 2048 + c8));
            u32x4 o;
#pragma unroll
            for (int q = 0; q < 4; ++q) {
                const float z0 = bflo(um[q]) * w0[2 * q] + bflo(uc[q]) * w1[2 * q] + bflo(un[q]) * w2[2 * q];
                const float z1 = bfhi(um[q]) * w0[2 * q + 1] + bfhi(uc[q]) * w1[2 * q + 1] + bfhi(un[q]) * w2[2 * q + 1];
                o[q] = pk2(bflo(bb[q]) * z0, bfhi(bb[q]) * z1);
            }
            *(u32x4*)(H + (size_t)r * DM + c8) = o;
        }
        return;
    }
    for (int idx = gt; idx < T * 128; idx += NT_) {
        const int r = idx >> 7, c8 = (idx & 127) * 8; const int b = r / RPB, w = r - b * RPB;
        if (latonly && w < CTXL) continue;
        const bool hp = !(w == 0 || w == CTXL), hn = !(w == CTXL - 1 || w == RPB - 1);
        const bf16_t* up = BUF1 + (size_t)r * 2048 + 1024 + c8;
        const u32x4 zero = {0u, 0u, 0u, 0u};
        const u32x4 uc = *(const u32x4*)up, um = hp ? *(const u32x4*)(up - 2048) : zero, un = hn ? *(const u32x4*)(up + 2048) : zero;
        const u32x4 bb = *(const u32x4*)(BUF1 + (size_t)r * 2048 + c8);
        u32x4 o;
#pragma unroll
        for (int q = 0; q < 4; ++q) {
            const int ch = c8 + 2 * q;
            const float z0 = bflo(um[q]) * cw[ch] + bflo(uc[q]) * cw[DM + ch] + bflo(un[q]) * cw[2 * DM + ch];
            const float z1 = bfhi(um[q]) * cw[ch + 1] + bfhi(uc[q]) * cw[DM + ch + 1] + bfhi(un[q]) * cw[2 * DM + ch + 1];
            o[q] = pk2(bflo(bb[q]) * z0, bfhi(bb[q]) * z1);
        }
        *(u32x4*)(H + (size_t)r * DM + c8) = o;
    }
}

DI void gqa_qknorm_phase(bf16_t* QKV, const float* qg, const float* kg, const float* cosT, const float* sinT, int G) {
    const int tid = otid(), lane = tid & 63, gw = blockIdx.x * NWAVES + (tid >> 6), NGW = G * NWAVES;
    for (int r = gw; r < T; r += NGW) {
        const int b = r / RPB, w = r - b * RPB; const bool lat = w >= CTXL; const int pos = w - CTXL;
        const float c = lat ? cosT[pos * 64 + lane] : 1.f, s = lat ? sinT[pos * 64 + lane] : 0.f;
        bf16_t* p = QKV + (size_t)r * 1536;
        float x1[10], x2[10], sq[10];
#pragma unroll
        for (int hh = 0; hh < 10; ++hh) { x1[hh] = bf2f(p[hh * 128 + lane]); x2[hh] = bf2f(p[hh * 128 + 64 + lane]); }
#pragma unroll
        for (int hh = 0; hh < 10; ++hh) sq[hh] = x1[hh] * x1[hh] + x2[hh] * x2[hh];
#pragma unroll
        for (int o = 1; o < 64; o <<= 1)
#pragma unroll
            for (int hh = 0; hh < 10; ++hh) sq[hh] += __shfl_xor(sq[hh], o);
        const float qg1 = qg[lane], qg2 = qg[64 + lane], kg1 = kg[lane], kg2 = kg[64 + lane];
#pragma unroll
        for (int hh = 0; hh < 10; ++hh) {
            const float rstd = 1.0f / sqrtf(sq[hh] * (1.f / 128.f) + EPS);
            const float y1 = x1[hh] * rstd * (hh < 8 ? qg1 : kg1), y2 = x2[hh] * rstd * (hh < 8 ? qg2 : kg2);
            p[hh * 128 + lane] = (bf16_t)f2bf(y1 * c - y2 * s); p[hh * 128 + 64 + lane] = (bf16_t)f2bf(y1 * s + y2 * c);
        }
    }
}

DI void mla_norm_phase(const float* C1, const float* qg, const float* kvg, const float* cosT, const float* sinT, bf16_t* CQ, bf16_t* CKV, bf16_t* KPE, int G) {
    const int tid = otid(), lane = tid & 63, gw = blockIdx.x * NWAVES + (tid >> 6), NGW = G * NWAVES;
    for (int r = gw; r < T; r += NGW) {
        const int b = r / RPB, w = r - b * RPB; const bool lat = w >= CTXL; const int pos = w - CTXL;
        const float* cr = C1 + (size_t)r * 1280;
        f32x4 v[3]; float ss = 0.f;
#pragma unroll
        for (int j = 0; j < 3; ++j) { v[j] = ((const f32x4*)cr)[lane + 64 * j]; ss += (v[j].x * v[j].x + v[j].y * v[j].y) + (v[j].z * v[j].z + v[j].w * v[j].w); }
        const float rq = 1.0f / sqrtf(wave_sum(ss) * (1.f / 768.f) + EPS);
#pragma unroll
        for (int j = 0; j < 3; ++j) { const int col = 4 * (lane + 64 * j); const f32x4 gv = *(const f32x4*)(qg + col); const f32x4 o = v[j] * rq * gv;
            u32x2 w2; w2.x = pk2(o.x, o.y); w2.y = pk2(o.z, o.w); *(u32x2*)(CQ + (size_t)r * 768 + col) = w2; }
        const f32x4 kv = ((const f32x4*)(cr + 768))[lane];
        const float rk = 1.0f / sqrtf(wave_sum((kv.x * kv.x + kv.y * kv.y) + (kv.z * kv.z + kv.w * kv.w)) * (1.f / 256.f) + EPS);
        { const f32x4 gv = *(const f32x4*)(kvg + 4 * lane); const f32x4 o = kv * rk * gv;
          u32x2 w2; w2.x = pk2(o.x, o.y); w2.y = pk2(o.z, o.w); *(u32x2*)(CKV + (size_t)r * 256 + 4 * lane) = w2; }
        if (lane < 32) { const float x1 = cr[1024 + lane], x2 = cr[1056 + lane];
            const float c = lat ? cosT[pos * 32 + lane] : 1.f, s = lat ? sinT[pos * 32 + lane] : 0.f;
            KPE[(size_t)r * 64 + lane] = (bf16_t)f2bf(x1 * c - x2 * s); KPE[(size_t)r * 64 + 32 + lane] = (bf16_t)f2bf(x1 * s + x2 * c); }
    }
}

template <int DQK, int LDQ, int LDK, int SDEPTH>
DI void attn_phase(const bf16_t* Q, int qhs, const bf16_t* Kb, const bf16_t* Vb, int khs, int kdiv, const bf16_t* KPE, bf16_t* O, char* lds, int G, int nunits) {
    for (int u = blockIdx.x; u < nunits; u += G) {
        int b, h, qrow, nk;
        if (u < 512) { h = u & 7; const int qb = (u >> 3) & 7; b = u >> 6; qrow = b * RPB + CTXL + qb * 256; nk = RPB; }
        else { const int uc = u - 512; h = uc & 7; b = uc >> 3; qrow = b * RPB; nk = CTXL; }
        const int kvh = h / kdiv; const size_t krow = (size_t)b * RPB;
        att::attn_body<DQK, LDQ, LDK, SDEPTH>(Q + (size_t)qrow * LDQ + h * qhs, Kb + krow * LDK + kvh * khs, Vb + krow * LDK + kvh * khs, KPE + krow * 64,
                                               O + (size_t)qrow * DM + h * 128, nk, lds);
        __syncthreads();
    }
}

#define XB_TMO      128
#define XB_XCNT(j)  (256  + 64 * (j))
#define XB_XSUB(j)  (1280 + 64 * (j))
#define XB_XGEN(j)  (2304 + 64 * (j))
#define XB_TOP      3328
#define XB_TOPGEN   3392
#define XCD_BAR_WORDS 3456
#define XB_SPIN_CAP (1u << 20)
DI unsigned xb_ld(unsigned* p)              { return __hip_atomic_load(p, __ATOMIC_RELAXED, __HIP_MEMORY_SCOPE_AGENT); }
DI unsigned xb_add(unsigned* p, unsigned v) { return __hip_atomic_fetch_add(p, v, __ATOMIC_RELAXED, __HIP_MEMORY_SCOPE_AGENT); }
DI unsigned xb_xcc_id() { return (unsigned)__builtin_amdgcn_s_getreg((3 << 11) | 20) & 0xFu; }
#define XB_SPIN(cond, bar) do { unsigned _sp = 0; while (cond) { __builtin_amdgcn_s_sleep(1); \
    if ((++_sp & 255u) == 0u) { if (xb_ld(&(bar)[XB_TMO])) break; if (_sp > XB_SPIN_CAP) { atomicAdd(&(bar)[XB_TMO], 1u); break; } } } } while (0)
struct XcdBarrier { unsigned* bar; unsigned x; volatile LAS unsigned* st; };
DI XcdBarrier xcd_barrier_post(unsigned* bar, volatile LAS unsigned* st) {
    XcdBarrier b; b.bar = bar; b.x = 0u; b.st = st;
    if (threadIdx.x == 0) { const unsigned x = xb_xcc_id(); st[2] = x; (void)xb_add(&bar[XB_XCNT(x)], 1u); }
    return b;
}
DI void xcd_barrier_complete(unsigned* bar, unsigned x, unsigned& nloc, unsigned& nx) {
    const unsigned G = gridDim.x * gridDim.y * gridDim.z;
    unsigned sum, cnt, mine, sp = 0u;
    for (;;) {
        sum = 0u; cnt = 0u; mine = 0u;
#pragma unroll
        for (unsigned j = 0; j < 16; ++j) { const unsigned c = xb_ld(&bar[XB_XCNT(j)]); sum += c; cnt += (c > 0u) ? 1u : 0u; mine = (j == x) ? c : mine; }
        if (sum == G) break;
        __builtin_amdgcn_s_sleep(1);
        if ((++sp & 255u) == 0u) { if (xb_ld(&bar[XB_TMO])) break; if (sp > XB_SPIN_CAP) { atomicAdd(&bar[XB_TMO], 1u); break; } }
    }
    nloc = mine > 0u ? mine : 1u; nx = cnt > 0u ? cnt : 1u;
}
DI void xcd_barrier(const XcdBarrier& b) {
    asm volatile("s_waitcnt vmcnt(0)" ::: "memory");
    __syncthreads();
    if (threadIdx.x == 0) {
        unsigned* bar = b.bar; asm volatile("" : "+s"(bar));
        __builtin_amdgcn_s_waitcnt(0);
        unsigned nloc = b.st[0], nx = b.st[1]; const unsigned bx = b.st[2];
        if (nloc == 0u) { xcd_barrier_complete(bar, bx, nloc, nx); b.st[0] = nloc; b.st[1] = nx; }
        const unsigned old = xb_add(&bar[XB_XSUB(bx)], 1u);
        const unsigned gen = old / nloc;
        if (old + 1u == (gen + 1u) * nloc) {
            __builtin_amdgcn_fence(__ATOMIC_RELEASE, "agent");
            asm volatile("s_waitcnt vmcnt(0)" ::: "memory");
            const unsigned og = xb_add(&bar[XB_TOP], 1u);
            const unsigned tg = og / nx;
            if (og + 1u == (tg + 1u) * nx) xb_add(&bar[XB_TOPGEN], 1u);
            else XB_SPIN(xb_ld(&bar[XB_TOPGEN]) == tg, bar);
            __builtin_amdgcn_fence(__ATOMIC_ACQUIRE, "agent");
            xb_add(&bar[XB_XGEN(bx)], 1u);
            asm volatile("s_waitcnt vmcnt(0)" ::: "memory");
        } else {
            XB_SPIN(xb_ld(&bar[XB_XGEN(bx)]) == gen, bar);
            __builtin_amdgcn_fence(__ATOMIC_ACQUIRE, "agent");
            asm volatile("s_waitcnt vmcnt(0)" ::: "memory");
        }
    }
    __syncthreads();
}

__global__ void __launch_bounds__(NTHREADS, 2) fwd_megakernel(Params P) {
    extern __shared__ __attribute__((aligned(16))) unsigned char lds_raw[];
    cg::grid_group grid = cg::this_grid();
    LAS unsigned char* lds = (LAS unsigned char*)lds_raw;
    const int G = gridDim.x;
    unsigned char* ws = P.ws;
    volatile LAS unsigned* MISC = (volatile LAS unsigned*)(lds + 131072);
    if (threadIdx.x < 16) MISC[threadIdx.x] = 0u;
    __syncthreads();
    const XcdBarrier xbar = xcd_barrier_post((unsigned*)(ws + WS_CTL), MISC + 8);
#define GRID_SYNC() xcd_barrier(xbar)
    float* XL = P.out; float* XC = (float*)(ws + WS_XC);
    const float* MOD = (const float*)(ws + WS_MOD);
    bf16_t* H = (bf16_t*)(ws + WS_H); bf16_t* BUF1 = (bf16_t*)(ws + WS_BUF1); bf16_t* ACT = (bf16_t*)(ws + WS_ACT);

    bf16_t* XS = (bf16_t*)(ws + WS_XS); float* SS = (float*)(ws + WS_SS);
    prologue_phase(P, lds, G);
    if (G > 65535) grid.sync();
    GRID_SYNC();
    prenorm_phase(P.in[0], P.in[2], P.in[6], MOD + 1 * DM, XS, SS, G);
    shw_phase(ws, lds, blockIdx.x, G, 0, 0, 136); shw_phase(ws, lds, blockIdx.x, G, 1, 0, 356);
    GRID_SYNC();

    for (int L = 0; L < 4; ++L) {
        const int kind = L % 3, j = L / 3; const bool latonly = (L == 3);
        const bool latout = (L >= 2);
        const float* srcL = (L == 0) ? P.in[0] : XL; const float* srcC = (L == 0) ? P.in[2] : XC;
        const float* modL = MOD + (size_t)L * 9 * NMOD;
        const float* ssA = SS + (size_t)(2 * L) * T; const float* ssB = SS + (size_t)(2 * L + 1) * T;
        const float* shwI = (const float*)(ws + WS_SHWI) + (size_t)L * 9 * 3072; const float* shwU = (const float*)(ws + WS_SHWU) + (size_t)L * 9 * 5632;
        const bf16_t* Wout;
        if (kind == 0) {
            { pg8::Gemm g{XS, (const bf16_t*)(ws + WS_WCI + j * SZ_WCI), DM, DM}; pg8::Sched S; S.init(latonly, 3072, G, blockIdx.x);
              pg8::Epi<pg8::EK_CONVIN> E{}; E.O = BUF1; E.ldc = 2048; E.ss = ssA; E.shw = shwI; E.shwN = 3072;
              pg8::gemm_phase(lds, g, S, E); }
            GRID_SYNC();
            conv_phase(BUF1, P.in[12] + (size_t)j * 3 * DM, H, latonly, G);
            GRID_SYNC();
            Wout = (const bf16_t*)(ws + WS_WCO + j * SZ_WSQ);
        } else if (kind == 1) {
            { pg8::Gemm g{XS, (const bf16_t*)(ws + WS_WQKV), DM, DM}; pg8::Sched S; S.init(0, 1536, G, blockIdx.x);
              pg8::Epi<pg8::EK_QKV> E{}; E.O = BUF1; E.ldc = 1536; E.ss = ssA; E.shw = shwI; E.shwN = 1536; E.g1 = P.in[17]; E.g2 = P.in[18];
              E.cosT = (const float*)(ws + WS_RGC); E.sinT = (const float*)(ws + WS_RGS); E.xlds = lds + 131072 + 4096;
              pg8::gemm_phase(lds, g, S, E); }
            GRID_SYNC();
            attn_phase<128, 1536, 1536, 2>(BUF1, 128, BUF1 + 1024, BUF1 + 1280, 128, 4, BUF1, H, (char*)lds_raw, G, 576);
            GRID_SYNC();
            Wout = (const bf16_t*)(ws + WS_WGO);
        } else {
            bf16_t* QM = (bf16_t*)(ws + WS_ACT);
            bf16_t* CQ = QM + (size_t)T * 1536; bf16_t* CKV = CQ + (size_t)T * 768; bf16_t* KPE = (bf16_t*)(ws + WS_KPE);
            float* SSQ = SS + (size_t)8 * T; float* SSKV = SS + (size_t)9 * T;
            { pg8::Gemm g{XS, (const bf16_t*)(ws + WS_WD), DM, DM}; pg8::Sched S; S.init(0, 1280, G, blockIdx.x);
              pg8::Epi<pg8::EK_MLAD> E{}; E.O = CQ; E.O2 = CKV; E.O3 = KPE; E.g1 = P.in[21]; E.g2 = P.in[24]; E.ssa = SSQ; E.ssb = SSKV;
              E.cosT = (const float*)(ws + WS_RMC); E.sinT = (const float*)(ws + WS_RMS); E.ss = ssA; E.shw = shwI; E.shwN = 1280;
              pg8::gemm_phase(lds, g, S, E); }
            GRID_SYNC();
            { pg8::Gemm g{CQ, (const bf16_t*)(ws + WS_WUQ), 768, 768}; pg8::Sched S; S.init(1, 1536, G, blockIdx.x, 768);
              pg8::Epi<pg8::EK_MLAQ> E{}; E.O = QM; E.ldc = 1536; E.cosT = (const float*)(ws + WS_RMC); E.sinT = (const float*)(ws + WS_RMS); E.ss = SSQ; E.inv_n = 1.f / 768.f;
              pg8::gemm_phase(lds, g, S, E); }
            { pg8::Gemm g{CKV, (const bf16_t*)(ws + WS_WUKV), 256, 256}; pg8::Sched S; S.init(0, 2048, G, blockIdx.x, 256, 1);
              pg8::Epi<pg8::EK_BF16> E{}; E.O = BUF1; E.ldc = 2048; E.ss = SSKV; E.inv_n = 1.f / 256.f;
              pg8::gemm_phase(lds, g, S, E); }
            GRID_SYNC();
            attn_phase<192, 1536, 2048, 1>(QM, 192, BUF1, BUF1 + 128, 256, 1, KPE, H, (char*)lds_raw, G, 512);
            GRID_SYNC();
            Wout = (const bf16_t*)(ws + WS_WMO);
        }
        const bool splitk = !latout && G == 256;
        { pg8::Gemm g{H, Wout, DM, DM};
          pg8::Epi<pg8::EK_RESID> E{}; E.srcL = srcL; E.srcC = srcC; E.dstL = XL; E.dstC = XC; E.gate = modL + 2 * DM; E.slab = (float*)BUF1;
          E.gnext = P.in[7] + L * DM; E.scnext = modL + 4 * DM; E.ssnext = SS + (size_t)(2 * L + 1) * T; E.XS = XS;
          pg8::Sched S; S.init(latout, DM, G, blockIdx.x, DM, 0, splitk); pg8::gemm_phase(lds, g, S, E); }
        GRID_SYNC();
        if (splitk) {
            ctxfix_phase(srcC, XC, (const float*)BUF1, modL + 2 * DM, P.in[7] + L * DM, modL + 4 * DM, XS, SS + (size_t)(2 * L + 1) * T, G);
            GRID_SYNC();
        }
        { pg8::Gemm g{XS, (const bf16_t*)(ws + WS_WUP + L * SZ_WUP), DM, DM}; pg8::Sched S; S.init(latout, 2 * FF, G, blockIdx.x);
          pg8::Epi<pg8::EK_SWIGLU> E{}; E.O = ACT; E.ldc = FF; E.ss = ssB; E.shw = shwU; E.shwN = 5632;
          pg8::gemm_phase(lds, g, S, E); }
        GRID_SYNC();
        { pg8::Gemm g{ACT, (const bf16_t*)(ws + WS_WDN + L * SZ_WDN), FF, FF};
          pg8::Epi<pg8::EK_RESID> E{}; E.srcL = XL; E.srcC = XC; E.dstL = XL; E.dstC = XC; E.gate = modL + 5 * DM; E.slab = (float*)BUF1;
          if (L < 3) { E.gnext = P.in[6] + (L + 1) * DM; E.scnext = MOD + (size_t)(L + 1) * 9 * NMOD + 1 * DM; E.ssnext = SS + (size_t)(2 * L + 2) * T; E.XS = XS; }
          pg8::Sched S; S.init(latout, DM, G, blockIdx.x, FF, 0, splitk); pg8::gemm_phase(lds, g, S, E); }
        GRID_SYNC();
        if (splitk) {
            ctxfix_phase(XC, XC, (const float*)BUF1, modL + 5 * DM, P.in[6] + (L + 1) * DM, MOD + (size_t)(L + 1) * 9 * NMOD + 1 * DM, XS, SS + (size_t)(2 * L + 2) * T, G);
            GRID_SYNC();
        }
    }
    const int ftid = otid(), lane = ftid & 63, gw = blockIdx.x * NWAVES + (ftid >> 6), NGW = G * NWAVES;
    for (int r = gw; r < NB * SEQ; r += 2 * NGW) {
        const int r2 = r + NGW; const bool has2 = r2 < NB * SEQ;
        float* xr = XL + (size_t)r * DM; float* xr2 = XL + (size_t)(has2 ? r2 : r) * DM; f32x4 v[4], v2[4]; float ss = 0.f, ss2 = 0.f;
#pragma unroll
        for (int q = 0; q < 4; ++q) { v[q] = __builtin_nontemporal_load((const f32x4*)xr + lane + 64 * q); v2[q] = __builtin_nontemporal_load((const f32x4*)xr2 + lane + 64 * q); }
#pragma unroll
        for (int q = 0; q < 4; ++q) { ss += (v[q].x * v[q].x + v[q].y * v[q].y) + (v[q].z * v[q].z + v[q].w * v[q].w); ss2 += (v2[q].x * v2[q].x + v2[q].y * v2[q].y) + (v2[q].z * v2[q].z + v2[q].w * v2[q].w); }
#pragma unroll
        for (int o = 1; o < 64; o <<= 1) { ss += __shfl_xor(ss, o); ss2 += __shfl_xor(ss2, o); }
        const float rstd = 1.0f / sqrtf(ss * (1.f / DM) + EPS), rstd2 = 1.0f / sqrtf(ss2 * (1.f / DM) + EPS);
#pragma unroll
        for (int q = 0; q < 4; ++q) { const f32x4 gv = ((const f32x4*)P.in[27])[lane + 64 * q]; __builtin_nontemporal_store(v[q] * rstd * gv, (f32x4*)xr + lane + 64 * q); if (has2) __builtin_nontemporal_store(v2[q] * rstd2 * gv, (f32x4*)xr2 + lane + 64 * q); }
    }
}

extern "C" void kernel_launch(void* const* d_in, const int* in_sizes, int n_in, void* d_out, int out_size, void* d_ws, size_t ws_size, hipStream_t stream) {
    static int grid = 0;
    if (grid == 0) {
        if (n_in != 28 || in_sizes[0] != NB * SEQ * DM || out_size != NB * SEQ * DM || ws_size < WS_END) {
            fprintf(stderr, "kernel_launch: shape/workspace mismatch: n_in %d in0 %d out %d ws %zu (need %zu)\n", n_in, n_in > 0 ? in_sizes[0] : -1, out_size, ws_size, (size_t)WS_END); grid = -1; return; }
        int dev = 0, cus = 0, per_cu = 0;
        if (hipGetDevice(&dev) != hipSuccess || hipDeviceGetAttribute(&cus, hipDeviceAttributeMultiprocessorCount, dev) != hipSuccess) { grid = -1; return; }
        if (hipFuncSetAttribute((const void*)fwd_megakernel, hipFuncAttributeMaxDynamicSharedMemorySize, LDS_BYTES) != hipSuccess) { fprintf(stderr, "kernel_launch: hipFuncSetAttribute failed\n"); grid = -1; return; }
        if (hipOccupancyMaxActiveBlocksPerMultiprocessor(&per_cu, (const void*)fwd_megakernel, NTHREADS, LDS_BYTES) != hipSuccess || per_cu < 1) { fprintf(stderr, "kernel_launch: occupancy query says %d\n", per_cu); per_cu = 1; }
        (void)hipGetLastError();
        grid = cus;
    }
    if (grid < 0) return;
    Params p{};
    for (int i = 0; i < 28; ++i) p.in[i] = (const float*)d_in[i];
    p.out = (float*)d_out; p.ws = (unsigned char*)d_ws;
    if (hipMemsetAsync((char*)d_ws + WS_CTL, 0, CTL_BYTES, stream) != hipSuccess) { fprintf(stderr, "kernel_launch: memset failed\n"); return; }
    void* args[] = {&p};
    hipError_t e = hipLaunchCooperativeKernel((const void*)fwd_megakernel, dim3(grid), dim3(NTHREADS), args, LDS_BYTES, stream);
    if (e != hipSuccess) fprintf(stderr, "kernel_launch: cooperative launch failed: %s (grid %d)\n", hipGetErrorString(e), grid);
}
```

```cpp
#include <hip/hip_runtime.h>
#include <hip/hip_cooperative_groups.h>
#include <cstdio>
#include <cstdint>
namespace cg = cooperative_groups;

#define LAS __attribute__((address_space(3)))
typedef unsigned short bf16_t;
typedef short bf16x8 __attribute__((ext_vector_type(8)));
typedef short s16x4 __attribute__((ext_vector_type(4)));
typedef float f32x4 __attribute__((ext_vector_type(4)));
typedef float f32x16 __attribute__((ext_vector_type(16)));
typedef unsigned u32x4 __attribute__((ext_vector_type(4)));
typedef unsigned u32x2 __attribute__((ext_vector_type(2)));
#define DI __device__ __forceinline__

constexpr int NB = 8, SEQ = 2048, DM = 1024, CTXL = 256, RPB = SEQ + CTXL  , T = NB * RPB  ;
constexpr int FF = 2816, NMOD = 6 * DM;
constexpr float EPS = 1e-6f;
constexpr int NTHREADS = 512, NWAVES = 8;

constexpr size_t AL(size_t x) { return (x + 255) / 256 * 256; }
constexpr size_t WS_XC = 0;
constexpr size_t WS_MOD = WS_XC + AL((size_t)NB * CTXL * DM * 4);
constexpr size_t WS_RGC = WS_MOD + AL((size_t)4 * 9 * NMOD * 4);
constexpr size_t WS_RGS = WS_RGC + AL((size_t)SEQ * 64 * 4);
constexpr size_t WS_RMC = WS_RGS + AL((size_t)SEQ * 64 * 4);
constexpr size_t WS_RMS = WS_RMC + AL((size_t)SEQ * 32 * 4);
constexpr size_t WS_H = WS_RMS + AL((size_t)SEQ * 32 * 4);
constexpr size_t WS_BUF1 = WS_H + AL((size_t)T * DM * 2);
constexpr size_t WS_ACT = WS_BUF1 + AL((size_t)T * 2048 * 2);
constexpr size_t WS_CQ = WS_ACT + AL((size_t)T * FF * 2);
constexpr size_t WS_CKV = WS_CQ + AL((size_t)T * 768 * 2);
constexpr size_t WS_KPE = WS_CKV + AL((size_t)T * 256 * 2);
constexpr size_t WS_WUP = WS_KPE + AL((size_t)T * 64 * 2);
constexpr size_t SZ_WUP = (size_t)2 * FF * DM * 2;
constexpr size_t WS_WDN = WS_WUP + 4 * SZ_WUP;
constexpr size_t SZ_WDN = (size_t)DM * FF * 2;
constexpr size_t WS_WCI = WS_WDN + 4 * SZ_WDN;
constexpr size_t SZ_WCI = (size_t)3072 * DM * 2;
constexpr size_t WS_WCO = WS_WCI + 2 * SZ_WCI;
constexpr size_t SZ_WSQ = (size_t)DM * DM * 2;
constexpr size_t WS_WQKV = WS_WCO + 2 * SZ_WSQ;
constexpr size_t WS_WGO = WS_WQKV + (size_t)1536 * DM * 2;
constexpr size_t WS_WD = WS_WGO + SZ_WSQ;
constexpr size_t WS_WUQ = WS_WD + (size_t)1280 * DM * 2;
constexpr size_t WS_WUKV = WS_WUQ + (size_t)1536 * 768 * 2;
constexpr size_t WS_WMO = WS_WUKV + (size_t)2048 * 256 * 2;
constexpr size_t WS_SS = WS_WMO + SZ_WSQ;
constexpr size_t WS_SHWI = WS_SS + AL((size_t)10 * T * 4);
constexpr size_t WS_SHWU = WS_SHWI + AL((size_t)4 * 9 * 3072 * 4);
constexpr size_t WS_CTL = WS_SHWU + AL((size_t)4 * 9 * 5632 * 4);
constexpr size_t CTL_BYTES = 16384;
constexpr size_t WS_END = WS_CTL + CTL_BYTES;
static_assert((size_t)T * (1536 + 768 + 256) * 2 <= (size_t)T * FF * 2, "QM | CQ | CKV fit in the FFN hidden buffer");
constexpr size_t WS_XS = WS_CQ;
static_assert(WS_CKV == WS_CQ + (size_t)T * 768 * 2 && WS_KPE == WS_CKV + (size_t)T * 256 * 2, "CQ|CKV contiguous = XS");
static_assert(WS_END <= (size_t)400 * 1000 * 1000, "workspace budget");

constexpr int LDS_BYTES = 131072 + 4096 + 4096;

struct Params { const float* in[28]; float* out; unsigned char* ws; };

DI unsigned f2bf(float f) { unsigned u = __float_as_uint(f); return (u + 0x7fffu + ((u >> 16) & 1u)) >> 16; }
DI unsigned pk2(float lo, float hi) { return f2bf(lo) | (f2bf(hi) << 16); }
DI float bf2f(unsigned short b) { return __uint_as_float(((unsigned)b) << 16); }
DI float bflo(unsigned w) { return __uint_as_float(w << 16); }
DI float bfhi(unsigned w) { return __uint_as_float(w & 0xffff0000u); }
DI unsigned cvt_pk_bf16(float lo, float hi) { unsigned r; asm volatile("v_cvt_pk_bf16_f32 %0, %1, %2" : "=v"(r) : "v"(lo), "v"(hi)); return r; }
DI float wave_sum(float v) {
#pragma unroll
    for (int o = 1; o < 64; o <<= 1) v += __shfl_xor(v, o);
    return v;
}
DI int otid() { int t = threadIdx.x; asm volatile("" : "+v"(t)); return t; }
#define LDS_WAIT() asm volatile("s_waitcnt lgkmcnt(0)" ::: "memory")

namespace pg8 {
constexpr int BM = 256, BK = 64, HALF = 128, HTB = HALF * BK * 2, STAGE_BYTES = 8 * HTB, NXCD = 8, WGM = 8;
DI int lds_byte(int r, int c) { const int st = (r >> 4) * 2 + (c >> 5), rr = r & 15, cc = c & 31, ob = rr * 64 + cc * 2; return st * 1024 + (ob ^ (((ob >> 9) & 1) << 5)); }
DI void stage_rc(int b, int& R, int& C) { const int st = b / 1024, sb = b % 1024, swz = sb ^ (((sb >> 9) & 1) << 5); R = (st >> 1) * 16 + swz / 64; C = (st & 1) * 32 + (swz % 64) / 2; }
DI int perm32(int rho) { const int n = rho >> 4, i = rho & 15; return 8 * (i >> 2) + 4 * n + (i & 3); }

struct Unit { int pm, pn, k0, nt, part; };
struct Gemm { const bf16_t* A; const bf16_t* Bt; int lda, K; };

struct Sched {
    int nM, nN, nwg, G, c, latonly, ntk, skew, split;
    DI void init(int latonly_, int N, int G_, int c_, int K_ = DM, int skew_ = 0, int split_ = 0) { latonly = latonly_; nM = latonly_ ? 64 : 72; nN = N / BM; nwg = nM * nN; G = G_; c = c_; ntk = K_ / BK; skew = skew_; split = split_; }
    DI bool next(int i, Unit& u) const {
        long L = (long)i * G + c;
        if (split) {
            if (L >= 256 + 128) return false;
            if (L < 256) { int wgid = (int)L; { const int q = 256 / NXCD, xcd = wgid % NXCD, off = wgid / NXCD; wgid = xcd * q + off; }
                const int nig = WGM * 4, gid = wgid / nig, fm = gid * WGM; const int pm = fm + ((wgid % nig) % WGM); u.pn = (wgid % nig) / WGM;
                u.pm = (pm >> 3) * 9 + 1 + (pm & 7); u.k0 = 0; u.nt = ntk; u.part = 0; }
            else { const int idx = (int)L - 256, tile = idx >> 2, seg = idx & 3; u.pm = (tile >> 2) * 9; u.pn = tile & 3; u.part = 1 + seg;
                if (ntk == 44) { u.k0 = (seg >> 1) * 22 + (seg & 1) * 12; u.nt = (seg & 1) ? 10 : 12; } else { u.k0 = seg * 4; u.nt = 4; } }
            return true;
        }
        if (skew && G == 256) {
            if (c < 128) { if (i > 0) return false; L = c; } else L = c + 128 * i; }
        if (L >= nwg) return false;
        u.k0 = 0; u.nt = ntk; u.part = 0;
        int wgid = (int)L; { const int q = nwg / NXCD, r = nwg % NXCD, xcd = wgid % NXCD, off = wgid / NXCD; wgid = (xcd < r ? xcd * (q + 1) : r * (q + 1) + (xcd - r) * q) + off; }
        const int nig = WGM * nN, gid = wgid / nig, fm = gid * WGM, gsz = (nM - fm) < WGM ? (nM - fm) : WGM;
        int pm = fm + ((wgid % nig) % gsz); u.pn = (wgid % nig) / gsz;
        u.pm = latonly ? (pm >> 3) * 9 + 1 + (pm & 7) : pm; return true;
    }
    DI void a_ready(const Unit&) const {}
    DI void done(const Unit&) const {}
};

template <class Epi, class SchedT>
DI void gemm_phase(LAS unsigned char* lds, const Gemm g, const SchedT& S, const Epi& E) {
    const int tid = otid(), wid = __builtin_amdgcn_readfirstlane(tid >> 6), lane = tid & 63, wr = wid >> 2, wc = wid & 3, fr = lane & 15, fq = lane >> 4;
    const int K = g.K, lda = g.lda;
    unsigned voffA[2], voffB[2];
#pragma unroll
    for (int i = 0; i < 2; ++i) { int R, C; stage_rc(tid * 16 + i * 8192, R, C); const int Rb = Epi::PERM ? ((R & ~31) + perm32(R & 31)) : R;
        voffA[i] = (unsigned)(R * lda + C) * 2u; voffB[i] = (unsigned)(Rb * K + C) * 2u; }
    const size_t kstep = (size_t)(BK * 2);
    const size_t hstepA = (size_t)HALF * lda * 2, hstepB = (size_t)HALF * K * 2;
    const size_t tstepA = 2 * hstepA, tstepB = 2 * hstepB;
    const unsigned ldsw = (unsigned)wid * 1024u;
    const int aoff = lds_byte(wr * 64 + fr, fq * 8), boff = lds_byte(wc * 32 + fr, fq * 8);
#define PG8_SA(b, h) (((b) * 2 + (h)) * HTB)
#define PG8_SB(b, h) ((4 + (b) * 2 + (h)) * HTB)
#define PG8_STAGE(bufoff, gbase, voff) do { _Pragma("unroll") for (int _i = 0; _i < 2; ++_i) \
        __builtin_amdgcn_global_load_lds((const unsigned*)((const char*)(gbase) + (voff)[_i]), (LAS unsigned*)(lds + (bufoff) + ldsw + _i * 8192), 16, 0, 0); } while (0)
#define PG8_LDA(dst, b, h) do { _Pragma("unroll") for (int m = 0; m < 4; ++m) _Pragma("unroll") for (int k = 0; k < 2; ++k) dst[m][k] = *(const LAS bf16x8*)(lds + PG8_SA(b, h) + aoff + m * 2048 + k * 1024); } while (0)
#define PG8_LDB(dst, b, h) do { _Pragma("unroll") for (int n = 0; n < 2; ++n) _Pragma("unroll") for (int k = 0; k < 2; ++k) dst[n][k] = *(const LAS bf16x8*)(lds + PG8_SB(b, h) + boff + n * 2048 + k * 1024); } while (0)
#define PG8_MMA(ai, bj, At, Bt) do { __builtin_amdgcn_s_setprio(1); _Pragma("unroll") for (int m = 0; m < 4; ++m) _Pragma("unroll") for (int n = 0; n < 2; ++n) _Pragma("unroll") for (int k = 0; k < 2; ++k) \
        acc[ai][bj][m][n] = __builtin_amdgcn_mfma_f32_16x16x32_bf16(Bt[n][k], At[m][k], acc[ai][bj][m][n], 0, 0, 0); __builtin_amdgcn_s_setprio(0); } while (0)
#define PG8_WAIT_V(n) asm volatile("s_waitcnt vmcnt(" #n ")" ::: "memory")
#define PG8_WAIT_L(n) asm volatile("s_waitcnt lgkmcnt(" #n ")" ::: "memory")
#define PG8_BAR __builtin_amdgcn_s_barrier()
#define PG8_SCHED __builtin_amdgcn_sched_barrier(0)
    Unit cur, nxt; int ui = 0;
    if (!S.next(0, cur)) return;
    f32x4 acc[2][2][4][2];
#pragma unroll
    for (int a = 0; a < 2; ++a)
#pragma unroll
        for (int b = 0; b < 2; ++b)
#pragma unroll
            for (int m = 0; m < 4; ++m)
#pragma unroll
                for (int n = 0; n < 2; ++n) acc[a][b][m][n] = (f32x4){0.f, 0.f, 0.f, 0.f};
    bf16x8 At[4][2], B0[2][2], B1[2][2];
    const char* cA = (const char*)g.A + (size_t)cur.pm * tstepA + (size_t)cur.k0 * kstep; const char* cB = (const char*)g.Bt + (size_t)cur.pn * tstepB + (size_t)cur.k0 * kstep;
    S.a_ready(cur);
    PG8_STAGE(PG8_SB(0, 0), cB, voffB); PG8_STAGE(PG8_SB(0, 1), cB + hstepB, voffB); PG8_STAGE(PG8_SA(0, 0), cA, voffA); PG8_STAGE(PG8_SA(0, 1), cA + hstepA, voffA);
    if (wr == 1) PG8_BAR;
    PG8_WAIT_V(2); PG8_BAR;
    PG8_STAGE(PG8_SB(1, 0), cB + kstep, voffB); PG8_STAGE(PG8_SA(1, 0), cA + kstep, voffA); PG8_STAGE(PG8_SB(1, 1), cB + hstepB + kstep, voffB);
    PG8_WAIT_V(6); PG8_BAR;
    for (;;) {
        const bool has_next = S.next(ui + 1, nxt);
        const char* nA = has_next ? (const char*)g.A + (size_t)nxt.pm * tstepA + (size_t)nxt.k0 * kstep : cA; const char* nB = has_next ? (const char*)g.Bt + (size_t)nxt.pn * tstepB + (size_t)nxt.k0 * kstep : cB;
        const int nt = cur.nt;
        for (int t = 0; t < nt; t += 2) {
            const bool last = (t == nt - 2);
            const char* a1 = cA + (size_t)(t + 1) * kstep;
            const char* a2 = last ? nA : cA + (size_t)(t + 2) * kstep; const char* b2 = last ? nB : cB + (size_t)(t + 2) * kstep;
            const char* a3 = a2 + kstep; const char* b3 = b2 + kstep;
            if (last && has_next) S.a_ready(nxt);
            PG8_LDB(B0, 0, 0); PG8_LDB(B1, 0, 1); PG8_SCHED; PG8_LDA(At, 0, 0); PG8_STAGE(PG8_SA(1, 1), a1 + hstepA, voffA);
            PG8_WAIT_V(8); PG8_WAIT_L(0); PG8_BAR; PG8_MMA(0, 0, At, B0); PG8_MMA(0, 1, At, B1); PG8_BAR; PG8_SCHED;
            PG8_LDA(At, 0, 1); PG8_STAGE(PG8_SB(0, 0), b2, voffB); PG8_STAGE(PG8_SB(0, 1), b2 + hstepB, voffB); PG8_STAGE(PG8_SA(0, 0), a2, voffA);
            PG8_WAIT_V(8); PG8_WAIT_L(0); PG8_BAR; PG8_MMA(1, 0, At, B0); PG8_MMA(1, 1, At, B1); PG8_BAR; PG8_SCHED;
            PG8_LDB(B0, 1, 0); PG8_LDB(B1, 1, 1); PG8_SCHED; PG8_LDA(At, 1, 0); PG8_STAGE(PG8_SA(0, 1), a2 + hstepA, voffA);
            PG8_WAIT_V(8); PG8_WAIT_L(0); PG8_BAR; PG8_MMA(0, 0, At, B0); PG8_MMA(0, 1, At, B1); PG8_BAR; PG8_SCHED;
            PG8_LDA(At, 1, 1); PG8_STAGE(PG8_SB(1, 0), b3, voffB); PG8_STAGE(PG8_SB(1, 1), b3 + hstepB, voffB); PG8_STAGE(PG8_SA(1, 0), a3, voffA);
            PG8_WAIT_V(8); PG8_WAIT_L(0); PG8_BAR; PG8_MMA(1, 0, At, B0); PG8_MMA(1, 1, At, B1); PG8_BAR; PG8_SCHED;
        }
        if (wr == 0) PG8_BAR;
        E(acc, cur, wr, wc, fr, fq); S.done(cur);
        if (!has_next) break;
#pragma unroll
        for (int a = 0; a < 2; ++a)
#pragma unroll
            for (int b = 0; b < 2; ++b)
#pragma unroll
                for (int m = 0; m < 4; ++m)
#pragma unroll
                    for (int n = 0; n < 2; ++n) acc[a][b][m][n] = (f32x4){0.f, 0.f, 0.f, 0.f};
        cur = nxt; cA = nA; cB = nB; ++ui;
        if (wr == 1) PG8_BAR;
    }
    PG8_WAIT_V(0);
    PG8_BAR;
#undef PG8_SA
#undef PG8_SB
#undef PG8_STAGE
#undef PG8_LDA
#undef PG8_LDB
#undef PG8_MMA
#undef PG8_WAIT_V
#undef PG8_WAIT_L
#undef PG8_BAR
#undef PG8_SCHED
}

enum { EK_CONVIN = 0, EK_RESID = 1, EK_BF16 = 2, EK_SWIGLU = 3, EK_F32 = 4, EK_MLAQ = 5, EK_MLAD = 6, EK_QKV = 7 };
typedef f32x4 AccT[2][2][4][2];

template <int KIND> struct Epi {
    static constexpr bool PERM = (KIND != EK_RESID && KIND != EK_F32);
    bf16_t* O; int ldc;
    float* Cf;
    const float* srcL; const float* srcC; float* dstL; float* dstC; const float* gate;
    const float* cosT; const float* sinT;
    float inv_n;
    LAS unsigned char* xlds;
    float* slab;
    bf16_t* O2; bf16_t* O3; const float* g1; const float* g2; float* ssa; float* ssb;
    const float* ss; const float* shw; int shwN;
    const float* gnext; const float* scnext; float* ssnext; bf16_t* XS;

    DI void coefs(int mi, int row0, int colbase, int nstep, float (&rs)[2][4], f32x4 (&sw)[2][2]) const {
        const float in_ = inv_n > 0.f ? inv_n : (1.f / DM);
#pragma unroll
        for (int ai = 0; ai < 2; ++ai)
#pragma unroll
            for (int m = 0; m < 4; ++m) rs[ai][m] = ss ? 1.0f / sqrtf(ss[row0 + ai * HALF + m * 16] * in_ + EPS) : 1.f;
#pragma unroll
        for (int bj = 0; bj < 2; ++bj)
#pragma unroll
            for (int n = 0; n < 2; ++n) sw[bj][n] = shw ? *(const f32x4*)(shw + (size_t)mi * shwN + colbase + bj * HALF + n * nstep) : (f32x4){0.f, 0.f, 0.f, 0.f};
    }

    DI void operator()(const AccT& acc, const Unit& u, int wr, int wc, int fr, int fq) const {
        const int row0 = u.pm * BM + wr * 64 + fr;
        const int mi_ = (u.pm % 9 == 0) ? 8 : u.pm / 9;
        if constexpr (KIND == EK_RESID) {
            const int b = u.pm / 9, tq = u.pm - b * 9, mi = tq == 0 ? 8 : b;
            const size_t rowbase = tq == 0 ? (size_t)b * CTXL : (size_t)b * SEQ + (size_t)(tq - 1) * 256;
            const float* src = tq == 0 ? srcC : srcL; float* dst = tq == 0 ? dstC : dstL;
            const int col0 = u.pn * BM + wc * 32 + 4 * fq;
            if (u.part) {
                float* sp = slab + (size_t)((b * 4 + u.pn) * 4 + (u.part - 1)) * 65536 + (size_t)(wr * 64 + fr) * 256 + wc * 32 + 4 * fq;
#pragma unroll
                for (int ai = 0; ai < 2; ++ai)
#pragma unroll
                    for (int m = 0; m < 4; ++m)
#pragma unroll
                        for (int bj = 0; bj < 2; ++bj)
#pragma unroll
                            for (int n = 0; n < 2; ++n) *(f32x4*)(sp + (ai * HALF + m * 16) * 256 + bj * HALF + n * 16) = acc[ai][bj][m][n];
                return;
            }
            f32x4 gv[2][2], gsv[2][2]; const bool fuse = gnext != nullptr;
#pragma unroll
            for (int bj = 0; bj < 2; ++bj)
#pragma unroll
                for (int n = 0; n < 2; ++n) { gv[bj][n] = *(const f32x4*)(gate + (size_t)mi * NMOD + col0 + bj * HALF + n * 16);
                    if (fuse) { const f32x4 g4 = *(const f32x4*)(gnext + col0 + bj * HALF + n * 16), s4 = *(const f32x4*)(scnext + (size_t)mi * NMOD + col0 + bj * HALF + n * 16); gsv[bj][n] = g4 * (s4 + 1.0f); }
                    else gsv[bj][n] = (f32x4){0.f, 0.f, 0.f, 0.f}; }
            float sq[2][4];
#pragma unroll
            for (int ai = 0; ai < 2; ++ai)
#pragma unroll
                for (int mh = 0; mh < 2; ++mh) {
                    f32x4 xv[2][2][2];
#pragma unroll
                    for (int mm = 0; mm < 2; ++mm)
#pragma unroll
                        for (int bj = 0; bj < 2; ++bj)
#pragma unroll
                            for (int n = 0; n < 2; ++n) xv[mm][bj][n] = *(const f32x4*)(src + (rowbase + wr * 64 + fr + ai * HALF + (2 * mh + mm) * 16) * DM + col0 + bj * HALF + n * 16);
#pragma unroll
                    for (int mm = 0; mm < 2; ++mm) { const int m = 2 * mh + mm; const size_t off = (rowbase + wr * 64 + fr + ai * HALF + m * 16) * DM + col0; float sacc = 0.f;
                        bf16_t* xsp = XS + (size_t)(row0 + ai * HALF + m * 16) * DM + col0;
#pragma unroll
                        for (int bj = 0; bj < 2; ++bj)
#pragma unroll
                            for (int n = 0; n < 2; ++n) { const size_t o = off + bj * HALF + n * 16;
                                const f32x4 xn = xv[mm][bj][n] + gv[bj][n] * acc[ai][bj][m][n];
                                *(f32x4*)(dst + o) = xn;
                                if (fuse) { sacc += (xn.x * xn.x + xn.y * xn.y) + (xn.z * xn.z + xn.w * xn.w); const f32x4 xs = xn * gsv[bj][n];
                                    u32x2 w2; w2.x = cvt_pk_bf16(xs.x, xs.y); w2.y = cvt_pk_bf16(xs.z, xs.w); *(u32x2*)(xsp + bj * HALF + n * 16) = w2; } }
                        sq[ai][m] = sacc; }
                }
            if (fuse) {
#pragma unroll
                for (int ai = 0; ai < 2; ++ai)
#pragma unroll
                    for (int m = 0; m < 4; ++m) { float t = sq[ai][m]; t += __shfl_xor(t, 16); t += __shfl_xor(t, 32);
                        if (fq == 0) atomicAdd(ssnext + row0 + ai * HALF + m * 16, t); }
            }
        } else if constexpr (KIND == EK_F32) {
            const int col0 = u.pn * BM + wc * 32 + 4 * fq;
            float rs[2][4]; f32x4 sw[2][2]; coefs(mi_, row0, col0, 16, rs, sw);
#pragma unroll
            for (int ai = 0; ai < 2; ++ai)
#pragma unroll
                for (int m = 0; m < 4; ++m) { float* rowp = Cf + (size_t)(row0 + ai * HALF + m * 16) * ldc + col0;
#pragma unroll
                    for (int bj = 0; bj < 2; ++bj)
#pragma unroll
                        for (int n = 0; n < 2; ++n) *(f32x4*)(rowp + bj * HALF + n * 16) = acc[ai][bj][m][n] * rs[ai][m] + sw[bj][n]; }
        } else if constexpr (KIND == EK_BF16) {
            const int col0 = u.pn * BM + wc * 32 + 8 * fq;
            float rs[2][4]; f32x4 sw[2][2]; coefs(mi_, row0, col0, 4, rs, sw);
#pragma unroll
            for (int ai = 0; ai < 2; ++ai)
#pragma unroll
                for (int m = 0; m < 4; ++m) { bf16_t* rowp = O + (size_t)(row0 + ai * HALF + m * 16) * ldc + col0;
#pragma unroll
                    for (int bj = 0; bj < 2; ++bj) { const f32x4 v0 = acc[ai][bj][m][0] * rs[ai][m] + sw[bj][0], v1 = acc[ai][bj][m][1] * rs[ai][m] + sw[bj][1];
                        u32x4 w; w.x = cvt_pk_bf16(v0[0], v0[1]); w.y = cvt_pk_bf16(v0[2], v0[3]); w.z = cvt_pk_bf16(v1[0], v1[1]); w.w = cvt_pk_bf16(v1[2], v1[3]);
                        *(u32x4*)(rowp + bj * HALF) = w; } }
        } else if constexpr (KIND == EK_CONVIN) {
            float rs[2][4]; f32x4 sw[2][2]; coefs(mi_, row0, u.pn * BM + wc * 32 + 8 * fq, 4, rs, sw);
            if (u.pn < 4) {
                const int col0 = u.pn * BM + wc * 32 + 8 * fq;
#pragma unroll
                for (int ai = 0; ai < 2; ++ai)
#pragma unroll
                    for (int m = 0; m < 4; ++m) { bf16_t* rowp = O + (size_t)(row0 + ai * HALF + m * 16) * 2048 + col0;
#pragma unroll
                        for (int bj = 0; bj < 2; ++bj) { const f32x4 v0 = acc[ai][bj][m][0] * rs[ai][m] + sw[bj][0], v1 = acc[ai][bj][m][1] * rs[ai][m] + sw[bj][1];
                            u32x4 w; w.x = cvt_pk_bf16(v0[0], v0[1]); w.y = cvt_pk_bf16(v0[2], v0[3]); w.z = cvt_pk_bf16(v1[0], v1[1]); w.w = cvt_pk_bf16(v1[2], v1[3]);
                            *(u32x4*)(rowp + bj * HALF) = w; } }
            } else {
                const int col0 = 1024 + (u.pn - 4) * HALF + wc * 32 + 8 * fq;
#pragma unroll
                for (int ai = 0; ai < 2; ++ai)
#pragma unroll
                    for (int m = 0; m < 4; ++m) { bf16_t* rowp = O + (size_t)(row0 + ai * HALF + m * 16) * 2048 + col0;
                        const f32x4 v0 = (acc[ai][0][m][0] * rs[ai][m] + sw[0][0]) * (acc[ai][1][m][0] * rs[ai][m] + sw[1][0]);
                        const f32x4 v1 = (acc[ai][0][m][1] * rs[ai][m] + sw[0][1]) * (acc[ai][1][m][1] * rs[ai][m] + sw[1][1]);
                        u32x4 w; w.x = cvt_pk_bf16(v0[0], v0[1]); w.y = cvt_pk_bf16(v0[2], v0[3]); w.z = cvt_pk_bf16(v1[0], v1[1]); w.w = cvt_pk_bf16(v1[2], v1[3]);
                        *(u32x4*)rowp = w; }
            }
        } else if constexpr (KIND == EK_SWIGLU) {
            const int col0 = u.pn * HALF + wc * 32 + 8 * fq;
            float rs[2][4]; f32x4 sw[2][2]; coefs(mi_, row0, u.pn * BM + wc * 32 + 8 * fq, 4, rs, sw);
#pragma unroll
            for (int ai = 0; ai < 2; ++ai)
#pragma unroll
                for (int m = 0; m < 4; ++m) { bf16_t* rowp = O + (size_t)(row0 + ai * HALF + m * 16) * FF + col0;
                    f32x4 v[2];
#pragma unroll
                    for (int n = 0; n < 2; ++n) { const f32x4 a = acc[ai][0][m][n] * rs[ai][m] + sw[0][n], bb = acc[ai][1][m][n] * rs[ai][m] + sw[1][n];
                        const f32x4 t = a * (-1.4426950408889634f); f32x4 e;
                        e.x = __builtin_amdgcn_exp2f(t.x); e.y = __builtin_amdgcn_exp2f(t.y); e.z = __builtin_amdgcn_exp2f(t.z); e.w = __builtin_amdgcn_exp2f(t.w);
                        const f32x4 d = e + 1.0f; f32x4 r;
                        r.x = __builtin_amdgcn_rcpf(d.x); r.y = __builtin_amdgcn_rcpf(d.y); r.z = __builtin_amdgcn_rcpf(d.z); r.w = __builtin_amdgcn_rcpf(d.w);
                        v[n] = (a * bb) * r; }
                    u32x4 w; w.x = cvt_pk_bf16(v[0][0], v[0][1]); w.y = cvt_pk_bf16(v[0][2], v[0][3]); w.z = cvt_pk_bf16(v[1][0], v[1][1]); w.w = cvt_pk_bf16(v[1][2], v[1][3]);
                    *(u32x4*)rowp = w; }
        } else if constexpr (KIND == EK_QKV) {
            float rs[2][4]; f32x4 sw[2][2]; coefs(mi_, row0, u.pn * BM + wc * 32 + 8 * fq, 4, rs, sw);
            LAS float* xch = (LAS float*)xlds;
            const int wid8 = wr * 4 + wc;
            f32x4 v[2][4][2][2];
#pragma unroll
            for (int ai = 0; ai < 2; ++ai)
#pragma unroll
                for (int m = 0; m < 4; ++m) { float sacc = 0.f;
#pragma unroll
                    for (int bj = 0; bj < 2; ++bj)
#pragma unroll
                        for (int n = 0; n < 2; ++n) { const f32x4 t = acc[ai][bj][m][n] * rs[ai][m] + sw[bj][n]; v[ai][m][bj][n] = t; sacc += (t.x * t.x + t.y * t.y) + (t.z * t.z + t.w * t.w); }
                    sacc += __shfl_xor(sacc, 16); sacc += __shfl_xor(sacc, 32);
                    if (fq == 0) xch[wid8 * 128 + (ai * 4 + m) * 16 + fr] = sacc; }
            asm volatile("s_waitcnt lgkmcnt(0)" ::: "memory"); __builtin_amdgcn_s_barrier(); asm volatile("" ::: "memory");
            if (u.pn < 5) {
                const int hd = 2 * u.pn + (wc >> 1), dd = 32 * (wc & 1) + 8 * fq;
                const float* gg = (u.pn < 4 ? g1 : g2);
                f32x4 ga[2][2];
#pragma unroll
                for (int bj = 0; bj < 2; ++bj)
#pragma unroll
                    for (int n = 0; n < 2; ++n) ga[bj][n] = *(const f32x4*)(gg + bj * 64 + dd + 4 * n);
                const int tq = u.pm % 9; const bool lat = tq != 0;
#pragma unroll
                for (int ai = 0; ai < 2; ++ai)
#pragma unroll
                    for (int m = 0; m < 4; ++m) { const int slot = (ai * 4 + m) * 16 + fr, lrow = wr * 64 + fr + ai * HALF + m * 16;
                        const float tot = xch[wid8 * 128 + slot] + xch[(wid8 ^ 1) * 128 + slot];
                        const float rn = 1.0f / sqrtf(tot * (1.f / 128.f) + EPS);
                        bf16_t* rowp = O + (size_t)(u.pm * BM + lrow) * 1536 + hd * 128 + dd;
                        f32x4 o1[2], o2[2];
#pragma unroll
                        for (int n = 0; n < 2; ++n) { const f32x4 y1 = v[ai][m][0][n] * rn * ga[0][n], y2 = v[ai][m][1][n] * rn * ga[1][n];
                            if (lat) { const int pos = (tq - 1) * 256 + lrow; const f32x4 cv = *(const f32x4*)(cosT + pos * 64 + dd + 4 * n), sv = *(const f32x4*)(sinT + pos * 64 + dd + 4 * n);
                                o1[n] = y1 * cv - y2 * sv; o2[n] = y1 * sv + y2 * cv; }
                            else { o1[n] = y1; o2[n] = y2; } }
                        u32x4 w; w.x = cvt_pk_bf16(o1[0][0], o1[0][1]); w.y = cvt_pk_bf16(o1[0][2], o1[0][3]); w.z = cvt_pk_bf16(o1[1][0], o1[1][1]); w.w = cvt_pk_bf16(o1[1][2], o1[1][3]);
                        *(u32x4*)rowp = w;
                        w.x = cvt_pk_bf16(o2[0][0], o2[0][1]); w.y = cvt_pk_bf16(o2[0][2], o2[0][3]); w.z = cvt_pk_bf16(o2[1][0], o2[1][1]); w.w = cvt_pk_bf16(o2[1][2], o2[1][3]);
                        *(u32x4*)(rowp + 64) = w; }
            } else {
                const int col0 = u.pn * BM + wc * 32 + 8 * fq;
#pragma unroll
                for (int ai = 0; ai < 2; ++ai)
#pragma unroll
                    for (int m = 0; m < 4; ++m) { bf16_t* rowp = O + (size_t)(row0 + ai * HALF + m * 16) * 1536 + col0;
#pragma unroll
                        for (int bj = 0; bj < 2; ++bj) { const f32x4 v0 = v[ai][m][bj][0], v1 = v[ai][m][bj][1];
                            u32x4 w; w.x = cvt_pk_bf16(v0[0], v0[1]); w.y = cvt_pk_bf16(v0[2], v0[3]); w.z = cvt_pk_bf16(v1[0], v1[1]); w.w = cvt_pk_bf16(v1[2], v1[3]);
                            *(u32x4*)(rowp + bj * HALF) = w; } }
            }
            asm volatile("s_waitcnt lgkmcnt(0)" ::: "memory"); __builtin_amdgcn_s_barrier(); asm volatile("" ::: "memory");
        } else if constexpr (KIND == EK_MLAD) {
            float rs[2][4]; f32x4 sw[2][2]; coefs(mi_, row0, u.pn * BM + wc * 32 + 8 * fq, 4, rs, sw);
            if (u.pn < 4) {
                const bool isq = u.pn < 3;
                bf16_t* base = isq ? O : O2; const int ld = isq ? 768 : 256; const int cbase = (isq ? u.pn * BM : 0) + wc * 32 + 8 * fq;
                const float* gg = (isq ? g1 : g2) + cbase; float* ssp = isq ? ssa : ssb;
                f32x4 gvv[2][2];
#pragma unroll
                for (int bj = 0; bj < 2; ++bj)
#pragma unroll
                    for (int n = 0; n < 2; ++n) gvv[bj][n] = *(const f32x4*)(gg + bj * HALF + 4 * n);
#pragma unroll
                for (int ai = 0; ai < 2; ++ai)
#pragma unroll
                    for (int m = 0; m < 4; ++m) { const int row = row0 + ai * HALF + m * 16; float sacc = 0.f;
#pragma unroll
                        for (int bj = 0; bj < 2; ++bj) { const f32x4 v0 = acc[ai][bj][m][0] * rs[ai][m] + sw[bj][0], v1 = acc[ai][bj][m][1] * rs[ai][m] + sw[bj][1];
                            sacc += ((v0.x * v0.x + v0.y * v0.y) + (v0.z * v0.z + v0.w * v0.w)) + ((v1.x * v1.x + v1.y * v1.y) + (v1.z * v1.z + v1.w * v1.w));
                            const f32x4 o0 = v0 * gvv[bj][0], o1 = v1 * gvv[bj][1];
                            u32x4 w; w.x = cvt_pk_bf16(o0[0], o0[1]); w.y = cvt_pk_bf16(o0[2], o0[3]); w.z = cvt_pk_bf16(o1[0], o1[1]); w.w = cvt_pk_bf16(o1[2], o1[3]);
                            *(u32x4*)(base + (size_t)row * ld + cbase + bj * HALF) = w; }
                        sacc += __shfl_xor(sacc, 16); sacc += __shfl_xor(sacc, 32);
                        if (fq == 0) atomicAdd(ssp + row, sacc); }
            } else if (wc == 0) {
                const int tq = u.pm % 9; const bool lat = tq != 0;
#pragma unroll
                for (int ai = 0; ai < 2; ++ai)
#pragma unroll
                    for (int m = 0; m < 4; ++m) { const int lrow = wr * 64 + fr + ai * HALF + m * 16;
                        bf16_t* rowp = O3 + (size_t)(u.pm * BM + lrow) * 64 + 8 * fq;
                        f32x4 o1[2], o2[2];
#pragma unroll
                        for (int n = 0; n < 2; ++n) { const f32x4 x1 = acc[ai][0][m][n] * rs[ai][m] + sw[0][n], x2 = acc[ai][1][m][n] * rs[ai][m] + sw[1][n];
                            if (lat) { const int pos = (tq - 1) * 256 + lrow; const f32x4 cv = *(const f32x4*)(cosT + pos * 32 + 8 * fq + 4 * n), sv = *(const f32x4*)(sinT + pos * 32 + 8 * fq + 4 * n);
                                o1[n] = x1 * cv - x2 * sv; o2[n] = x1 * sv + x2 * cv; }
                            else { o1[n] = x1; o2[n] = x2; } }
                        u32x4 w; w.x = cvt_pk_bf16(o1[0][0], o1[0][1]); w.y = cvt_pk_bf16(o1[0][2], o1[0][3]); w.z = cvt_pk_bf16(o1[1][0], o1[1][1]); w.w = cvt_pk_bf16(o1[1][2], o1[1][3]);
                        *(u32x4*)rowp = w;
                        w.x = cvt_pk_bf16(o2[0][0], o2[0][1]); w.y = cvt_pk_bf16(o2[0][2], o2[0][3]); w.z = cvt_pk_bf16(o2[1][0], o2[1][1]); w.w = cvt_pk_bf16(o2[1][2], o2[1][3]);
                        *(u32x4*)(rowp + 32) = w; }
            }
        } else {
            float rs[2][4]; f32x4 sw[2][2]; coefs(mi_, row0, 0, 4, rs, sw);
            if (u.pn < 4) {
#pragma unroll
                for (int ai = 0; ai < 2; ++ai)
#pragma unroll
                    for (int m = 0; m < 4; ++m) { bf16_t* rowp = O + (size_t)(row0 + ai * HALF + m * 16) * 1536 + wc * 32 + 8 * fq;
#pragma unroll
                        for (int bj = 0; bj < 2; ++bj) { const f32x4 v0 = acc[ai][bj][m][0] * rs[ai][m], v1 = acc[ai][bj][m][1] * rs[ai][m];
                            u32x4 w; w.x = cvt_pk_bf16(v0[0], v0[1]); w.y = cvt_pk_bf16(v0[2], v0[3]); w.z = cvt_pk_bf16(v1[0], v1[1]); w.w = cvt_pk_bf16(v1[2], v1[3]);
                            *(u32x4*)(rowp + (2 * u.pn + bj) * 192) = w; } }
            } else {
                const int head = 4 * (u.pn - 4) + wc, j0 = 8 * fq;
                const int tq = u.pm % 9; const bool lat = tq != 0;
#pragma unroll
                for (int ai = 0; ai < 2; ++ai)
#pragma unroll
                    for (int m = 0; m < 4; ++m) { const int lrow = wr * 64 + fr + ai * HALF + m * 16;
                        bf16_t* rowp = O + (size_t)(u.pm * BM + lrow) * 1536 + head * 192 + 128 + j0;
                        f32x4 o1[2], o2[2];
                        if (lat) { const int pos = (tq - 1) * 256 + lrow;
#pragma unroll
                            for (int n = 0; n < 2; ++n) { const f32x4 cv = *(const f32x4*)(cosT + pos * 32 + j0 + 4 * n), sv = *(const f32x4*)(sinT + pos * 32 + j0 + 4 * n);
                                const f32x4 x1 = acc[ai][0][m][n] * rs[ai][m], x2 = acc[ai][1][m][n] * rs[ai][m]; o1[n] = x1 * cv - x2 * sv; o2[n] = x1 * sv + x2 * cv; }
                        } else { o1[0] = acc[ai][0][m][0] * rs[ai][m]; o1[1] = acc[ai][0][m][1] * rs[ai][m]; o2[0] = acc[ai][1][m][0] * rs[ai][m]; o2[1] = acc[ai][1][m][1] * rs[ai][m]; }
                        u32x4 w; w.x = cvt_pk_bf16(o1[0][0], o1[0][1]); w.y = cvt_pk_bf16(o1[0][2], o1[0][3]); w.z = cvt_pk_bf16(o1[1][0], o1[1][1]); w.w = cvt_pk_bf16(o1[1][2], o1[1][3]);
                        *(u32x4*)rowp = w;
                        w.x = cvt_pk_bf16(o2[0][0], o2[0][1]); w.y = cvt_pk_bf16(o2[0][2], o2[0][3]); w.z = cvt_pk_bf16(o2[1][0], o2[1][1]); w.w = cvt_pk_bf16(o2[1][2], o2[1][3]);
                        *(u32x4*)(rowp + 32) = w; }
            }
        }
    }
};
}

namespace att {
constexpr int NW = 8, QBLK = 32, KVBLK = 64;
constexpr float THR = 8.f;
constexpr int SHM_V = KVBLK * 128 * 2;
#define SBAR() __builtin_amdgcn_sched_barrier(0)
DI int crow(int r, int hi) { return (r & 3) + 8 * (r >> 2) + 4 * hi; }
DI unsigned cvtpk(float lo, float hi) { unsigned r; asm volatile("v_cvt_pk_bf16_f32 %0, %1, %2" : "=v"(r) : "v"(lo), "v"(hi)); return r; }
DI bf16x8 ld8(const bf16_t* p) { return *reinterpret_cast<const bf16x8*>(p); }

template <int DQK> struct Sc { static constexpr float SCALE = DQK == 128 ? 0.088388347648318440f : 0.072168783648703220f; };

template <int DQK>
DI void partialSM(f32x16& p0, f32x16& p1, float& m_reg, float& mn, float& alpha) {
  constexpr float SCALE = Sc<DQK>::SCALE;
  constexpr float C = SCALE * 1.4426950408889634f;
  float pmax = p0[0];
#pragma unroll
  for (int r = 1; r < 16; ++r) pmax = fmaxf(pmax, p0[r]);
#pragma unroll
  for (int r = 0; r < 16; ++r) pmax = fmaxf(pmax, p1[r]);
  { auto rr = __builtin_amdgcn_permlane32_swap(__float_as_uint(pmax), __float_as_uint(pmax), false, false);
    pmax = fmaxf(__uint_as_float(rr[0]), __uint_as_float(rr[1])); }
  if (__builtin_expect(__all(pmax - m_reg <= THR / SCALE), 1)) { mn = m_reg; alpha = 1.f; }
  else { mn = fmaxf(m_reg, pmax); alpha = __builtin_amdgcn_exp2f((m_reg - mn) * C); m_reg = mn; }
  float mnC = -mn * C;
#pragma unroll
  for (int r = 0; r < 16; ++r) p0[r] = fmaf(p0[r], C, mnC);
#pragma unroll
  for (int r = 0; r < 16; ++r) p1[r] = fmaf(p1[r], C, mnC);
#pragma unroll
  for (int r = 0; r < 16; ++r) p0[r] = __builtin_amdgcn_exp2f(p0[r]);
}
DI void finishSM(f32x16& p0, f32x16& p1, float alpha, float& l_reg, bf16x8& pa0, bf16x8& pa1, bf16x8& pa2, bf16x8& pa3) {
#pragma unroll
  for (int r = 0; r < 16; ++r) p1[r] = __builtin_amdgcn_exp2f(p1[r]);
  float ps = 0;
#pragma unroll
  for (int r = 0; r < 16; ++r) ps += p0[r];
#pragma unroll
  for (int r = 0; r < 16; ++r) ps += p1[r];
  { auto rr = __builtin_amdgcn_permlane32_swap(__float_as_uint(ps), __float_as_uint(ps), false, false);
    ps = __uint_as_float(rr[0]) + __uint_as_float(rr[1]); }
  l_reg = l_reg * alpha + ps;
#define PK4(P, BASE, OUT) do { unsigned a0 = cvtpk(P[BASE + 0], P[BASE + 1]), a1 = cvtpk(P[BASE + 2], P[BASE + 3]);   \
    unsigned b0 = cvtpk(P[BASE + 4], P[BASE + 5]), b1 = cvtpk(P[BASE + 6], P[BASE + 7]);                              \
    auto r0 = __builtin_amdgcn_permlane32_swap(a0, b0, false, false); auto r1 = __builtin_amdgcn_permlane32_swap(a1, b1, false, false); \
    u32x4 w = {r0[0], r1[0], r0[1], r1[1]}; OUT = *reinterpret_cast<bf16x8*>(&w); } while (0)
  PK4(p0, 0, pa0); PK4(p0, 8, pa1); PK4(p1, 0, pa2); PK4(p1, 8, pa3);
#undef PK4
}
#define KSWZ2(row, colB, RB) ((row) * (RB) + ((colB) ^ (((row) & 7) << 4)))
template <int DQK>
DI void qkt(f32x16& p0, f32x16& p1, const char* Ks, const bf16x8* qr, const char* qx, int r32, int hi) {
  constexpr int RB = DQK * 2;
  p0 = f32x16{}; p1 = f32x16{};
#pragma unroll
  for (int d0 = 0; d0 < DQK / 16; ++d0) { int cb = (d0 * 16 + hi * 8) * 2;
    bf16x8 b0 = *reinterpret_cast<const bf16x8*>(Ks + KSWZ2(r32, cb, RB));
    bf16x8 b1 = *reinterpret_cast<const bf16x8*>(Ks + KSWZ2(32 + r32, cb, RB));
    bf16x8 qf; if (d0 < 8) qf = qr[d0 < 8 ? d0 : 0]; else qf = *reinterpret_cast<const bf16x8*>(qx + (d0 - 8) * 1024);
    p0 = __builtin_amdgcn_mfma_f32_32x32x16_bf16(b0, qf, p0, 0, 0, 0);
    p1 = __builtin_amdgcn_mfma_f32_32x32x16_bf16(b1, qf, p1, 0, 0, 0); }
}
DI int v_st(int k, int c) { const int kk = (k & ~0xC) | ((k & 4) << 1) | ((k & 8) >> 1); return ((kk >> 3) * 4 + (c >> 5)) * 512 + ((kk & 7) * 32 + (c & 31)) * 2; }
DI int v_rd_base(int lane) { return ((lane & 3) << 3) | (((lane >> 2) & 3) << 6) | (((lane >> 4) & 1) << 5) | (((lane >> 5) & 1) << 8); }
constexpr int v_rd_off(int d0, int ks, int half) { return d0 * 512 + ks * 4096 + half * 2048; }
template <int OFF> DI s16x4 tr_read(int vb) {
  s16x4 r; asm volatile("ds_read_b64_tr_b16 %0, %1 offset:%2" : "=&v"(r) : "v"(vb), "i"(OFF) : "memory"); return r;
}
template <int D0> DI void pv_one(f32x16& od, int vb, bf16x8 pa0, bf16x8 pa1, bf16x8 pa2, bf16x8 pa3) {
  const s16x4 l0 = tr_read<v_rd_off(D0, 0, 0)>(vb), h0 = tr_read<v_rd_off(D0, 0, 1)>(vb), l1 = tr_read<v_rd_off(D0, 1, 0)>(vb), h1 = tr_read<v_rd_off(D0, 1, 1)>(vb);
  const s16x4 l2 = tr_read<v_rd_off(D0, 2, 0)>(vb), h2 = tr_read<v_rd_off(D0, 2, 1)>(vb), l3 = tr_read<v_rd_off(D0, 3, 0)>(vb), h3 = tr_read<v_rd_off(D0, 3, 1)>(vb);
  asm volatile("s_waitcnt lgkmcnt(0)" ::: "memory"); SBAR();
#define PK(L, H) (bf16x8){L[0], L[1], L[2], L[3], H[0], H[1], H[2], H[3]}
  od = __builtin_amdgcn_mfma_f32_32x32x16_bf16(pa0, PK(l0, h0), od, 0, 0, 0);
  od = __builtin_amdgcn_mfma_f32_32x32x16_bf16(pa1, PK(l1, h1), od, 0, 0, 0);
  od = __builtin_amdgcn_mfma_f32_32x32x16_bf16(pa2, PK(l2, h2), od, 0, 0, 0);
  od = __builtin_amdgcn_mfma_f32_32x32x16_bf16(pa3, PK(l3, h3), od, 0, 0, 0);
#undef PK
}
DI void pv_d0(f32x16* o, int vb, bf16x8 pa0, bf16x8 pa1, bf16x8 pa2, bf16x8 pa3) {
  pv_one<0>(o[0], vb, pa0, pa1, pa2, pa3); pv_one<1>(o[1], vb, pa0, pa1, pa2, pa3); pv_one<2>(o[2], vb, pa0, pa1, pa2, pa3); pv_one<3>(o[3], vb, pa0, pa1, pa2, pa3);
}

template <int DQK, int LDQ, int LDK, int SDEPTH>
DI void attn_body(const bf16_t* Qb, const bf16_t* Kh, const bf16_t* Vh, const bf16_t* Ph, bf16_t* Ob, int seq, char* lds) {
  constexpr int ND = DQK / 16, KRB = DQK * 2, SHM_K = KVBLK * KRB, LDO = 1024;
  const int tid = otid(), wid = tid >> 6, lane = tid & 63, r32 = lane & 31, hi = lane >> 5;
  char* V_lds = lds; char* K_lds = lds + 2 * SHM_V;
  float* ws = (float*)(lds + 2 * SHM_V + 2 * SHM_K) + wid * 64; float* li_l = ws; float* al_l = ws + 32;
  float m_reg = -1e30f, l_reg = 0; f32x16 o[4] = {}; bf16x8 qr[8];
  const bf16_t* Qw = Qb + (long)(wid * QBLK + r32) * LDQ + hi * 8;
#pragma unroll
  for (int d0 = 0; d0 < 8; ++d0) qr[d0] = ld8(Qw + d0 * 16);
  char* qx = lds + 2 * SHM_V + 2 * SHM_K + NW * 256 + wid * 4096 + lane * 16;
  if constexpr (DQK == 192) {
#pragma unroll
    for (int d0 = 8; d0 < ND; ++d0) *reinterpret_cast<bf16x8*>(qx + (d0 - 8) * 1024) = ld8(Qw + d0 * 16);
    asm volatile("s_waitcnt lgkmcnt(0)" ::: "memory");
  }
  const int sr = tid >> 4, sc = (tid & 15) * 8, vst0 = v_st(sr, sc), vst1 = v_st(32 + sr, sc);
  const int pr = tid >> 3, pc = (tid & 7) * 8;
  const int vb0 = (int)(uintptr_t)V_lds + v_rd_base(lane);
  struct { bf16x8 vs0, vs1, ks0, ks1, ps; } sr_[SDEPTH];
#define SLOAD(i, k0) do { sr_[i].vs0 = ld8(&Vh[(long)((k0) + sr) * LDK + sc]); sr_[i].vs1 = ld8(&Vh[(long)((k0) + 32 + sr) * LDK + sc]); \
    sr_[i].ks0 = ld8(&Kh[(long)((k0) + sr) * LDK + sc]); sr_[i].ks1 = ld8(&Kh[(long)((k0) + 32 + sr) * LDK + sc]);                       \
    if constexpr (DQK == 192) sr_[i].ps = ld8(&Ph[(long)((k0) + pr) * 64 + pc]); } while (0)
#define SWRITE(b, i) do { *(bf16x8*)(V_lds + (b) * SHM_V + vst0) = sr_[i].vs0;          \
    *(bf16x8*)(V_lds + (b) * SHM_V + vst1) = sr_[i].vs1; int kc = sc * 2;               \
    *(bf16x8*)(K_lds + (b) * SHM_K + KSWZ2(sr, kc, KRB)) = sr_[i].ks0;                  \
    *(bf16x8*)(K_lds + (b) * SHM_K + KSWZ2(32 + sr, kc, KRB)) = sr_[i].ks1;             \
    if constexpr (DQK == 192) *(bf16x8*)(K_lds + (b) * SHM_K + KSWZ2(pr, 256 + pc * 2, KRB)) = sr_[i].ps; } while (0)
#define SWAIT() do { if constexpr (SDEPTH == 2) { if constexpr (DQK == 192) asm volatile("s_waitcnt vmcnt(5)" ::: "memory"); else asm volatile("s_waitcnt vmcnt(4)" ::: "memory"); } \
    else asm volatile("s_waitcnt vmcnt(0)" ::: "memory"); } while (0)
#define RESC(a) do { if (__any((a) < 1.f)) { if (hi == 0) al_l[r32] = (a); asm volatile("s_waitcnt lgkmcnt(0)" ::: "memory"); \
    _Pragma("unroll") for (int d = 0; d < 4; ++d) _Pragma("unroll") for (int r = 0; r < 16; ++r) o[d][r] *= al_l[crow(r, hi)]; } } while (0)
  f32x16 pA0, pA1, pB0, pB1; float mnA, mnB, alA, alB; bf16x8 pa0, pa1, pa2, pa3; const int NT = seq / KVBLK;
  constexpr int SE = 0, SO = SDEPTH - 1;
  SLOAD(SE, 0); asm volatile("s_waitcnt vmcnt(0)" ::: "memory"); SWRITE(0, SE); __syncthreads();
  qkt<DQK>(pA0, pA1, K_lds, qr, qx, r32, hi); partialSM<DQK>(pA0, pA1, m_reg, mnA, alA);
  SLOAD(SO, KVBLK); if constexpr (SDEPTH == 2) { if (2 < NT) SLOAD(SE, 2 * KVBLK); }
  SWAIT(); SWRITE(1, SO); __syncthreads();
  for (int j = 1; j + 1 < NT; j += 2) {
    SBAR(); qkt<DQK>(pB0, pB1, K_lds + SHM_K, qr, qx, r32, hi);
    finishSM(pA0, pA1, alA, l_reg, pa0, pa1, pa2, pa3); SBAR();
    SLOAD(SO, (j + SDEPTH) * KVBLK); SBAR();
    pv_d0(o, vb0, pa0, pa1, pa2, pa3); partialSM<DQK>(pB0, pB1, m_reg, mnB, alB);
    __syncthreads(); SWAIT(); SWRITE(0, SE);
    RESC(alB); __syncthreads();
    SBAR(); qkt<DQK>(pA0, pA1, K_lds, qr, qx, r32, hi);
    finishSM(pB0, pB1, alB, l_reg, pa0, pa1, pa2, pa3); SBAR();
    if (SDEPTH == 1 || j + 3 < NT) SLOAD(SE, (j + 1 + SDEPTH) * KVBLK); SBAR();
    pv_d0(o, vb0 + (int)SHM_V, pa0, pa1, pa2, pa3); partialSM<DQK>(pA0, pA1, m_reg, mnA, alA);
    __syncthreads(); SWAIT(); SWRITE(1, SO);
    RESC(alA); __syncthreads();
  }
  SBAR(); qkt<DQK>(pB0, pB1, K_lds + SHM_K, qr, qx, r32, hi);
  finishSM(pA0, pA1, alA, l_reg, pa0, pa1, pa2, pa3); SBAR();
  pv_d0(o, vb0, pa0, pa1, pa2, pa3); partialSM<DQK>(pB0, pB1, m_reg, mnB, alB);
  __syncthreads(); RESC(alB);
  finishSM(pB0, pB1, alB, l_reg, pa0, pa1, pa2, pa3); SBAR();
  pv_d0(o, vb0 + (int)SHM_V, pa0, pa1, pa2, pa3);
  if (hi == 0) li_l[r32] = l_reg; asm volatile("s_waitcnt lgkmcnt(0)" ::: "memory");
  float rli[16];
#pragma unroll
  for (int r = 0; r < 16; ++r) rli[r] = __builtin_amdgcn_rcpf(li_l[crow(r, hi)]);
  bf16_t* Ow = Ob + (long)(wid * QBLK) * LDO;
#pragma unroll
  for (int r = 0; r < 16; ++r) { int orow = crow(r, hi);
#pragma unroll
    for (int d0 = 0; d0 < 4; ++d0) Ow[(long)orow * LDO + d0 * 32 + r32] = (bf16_t)f2bf(o[d0][r] * rli[r]); }
#undef SLOAD
#undef SWRITE
#undef SWAIT
#undef RESC
}
}

DI int wrow(int mode, int p0, int n) {
    if (mode == 0) return p0 + n;
    if (mode == 1) { if (n < 1024) return n; const int s = (n - 1024) >> 10, ch = (n - 1024) & 1023; return 1024 + ((ch >> 7) << 8) + (s << 7) + (ch & 127); }
    if (mode == 2) return ((n >> 7) << 8) + (p0 << 7) + (n & 127);
    if (mode == 5) { const int hd = n >> 7, d = n & 127; return p0 + ((hd >> 1) << 8) + ((d >> 6) << 7) + ((hd & 1) << 6) + (d & 63); }
    if (mode == 4) { if (n < 256) return 768 + n; const int j = n - 256; return 1024 + ((j >> 5) << 7) + (j & 31); }
    const int h = n / 192, d = n - h * 192;
    if (d < 128) return ((h >> 1) << 8) + ((h & 1) << 7) + d;
    const int j = d - 128; return 1024 + ((h >> 2) << 8) + ((j >> 5) << 7) + ((h & 3) << 5) + (j & 31);
}
DI void transpose_item(const float* W, int K, int N, bf16_t* WT, int mode, int p0, LAS float* scr, int item, int lane) {
    const int nblk = N / 32, kb = item / nblk, nb = item - kb * nblk, k0 = 64 * kb, n0 = 32 * nb;
#pragma unroll
    for (int i = 0; i < 32; ++i) { const int kk = 2 * i + (lane >> 5); scr[kk * 33 + (lane & 31)] = __builtin_nontemporal_load(W + (size_t)(k0 + kk) * N + n0 + (lane & 31)); }
    LDS_WAIT(); asm volatile("" ::: "memory");
    const int c = lane & 7;
#pragma unroll
    for (int j = 0; j < 4; ++j) { const int n = (lane >> 3) + 8 * j; const LAS float* s = scr + (8 * c) * 33 + n;
        u32x4 o; o.x = pk2(s[0 * 33], s[1 * 33]); o.y = pk2(s[2 * 33], s[3 * 33]); o.z = pk2(s[4 * 33], s[5 * 33]); o.w = pk2(s[6 * 33], s[7 * 33]);
        *(u32x4*)(WT + (size_t)wrow(mode, p0, n0 + n) * K + k0 + 8 * c) = o; }
    LDS_WAIT(); asm volatile("" ::: "memory");
}

DI void transposes_items(const Params& P, LAS unsigned char* lds, int first, int last, int slot, int nslots, int deferred, int lane) {
    unsigned char* ws = P.ws; const int wave = otid() >> 6;
    LAS float* scr = (LAS float*)(lds + 61440 + wave * 8448);
    constexpr int I_FF = 1408, I_L = 3 * I_FF, I_CI = 1536, I_CO = 512, I_CV = I_CI + I_CO;
    constexpr int N0 = 4 * I_L, N1 = N0 + 2 * I_CV, N2 = N1 + 512 + 128 + 128 + 512, N3 = N2 + 384 + 160 + 576 + 256 + 512;
    static_assert(N3 - N0 - I_CV + 3 * I_L == 17888 && I_L + I_CV == 6272, "item counts");
    for (int d = first + slot; d < last; d += nslots) {
        int it;
        if (!deferred) it = d < I_L ? d : N0 + (d - I_L);
        else it = d < 3 * I_L ? I_L + d : N0 + I_CV + (d - 3 * I_L);
        const float* W; int K, N, mode = 0, p0 = 0, item; bf16_t* WT;
        if (it < N0) { const int l = it / I_L, q = it - l * I_L, wh = q / I_FF; item = q - wh * I_FF;
            if (wh == 0) { W = P.in[8] + (size_t)l * DM * FF; K = DM; N = FF; WT = (bf16_t*)(ws + WS_WUP + l * SZ_WUP); mode = 2; p0 = 0; }
            else if (wh == 1) { W = P.in[9] + (size_t)l * DM * FF; K = DM; N = FF; WT = (bf16_t*)(ws + WS_WUP + l * SZ_WUP); mode = 2; p0 = 1; }
            else { W = P.in[10] + (size_t)l * FF * DM; K = FF; N = DM; WT = (bf16_t*)(ws + WS_WDN + l * SZ_WDN); } }
        else if (it < N1) { const int r = it - N0, j = r / I_CV, q = r - j * I_CV;
            if (q < I_CI) { item = q; W = P.in[11] + (size_t)j * DM * 3072; K = DM; N = 3072; WT = (bf16_t*)(ws + WS_WCI + j * SZ_WCI); mode = 1; }
            else { item = q - I_CI; W = P.in[13] + (size_t)j * DM * DM; K = DM; N = DM; WT = (bf16_t*)(ws + WS_WCO + j * SZ_WSQ); } }
        else if (it < N2) { int r = it - N1;
            if (r < 512) { item = r; W = P.in[14]; K = DM; N = DM; WT = (bf16_t*)(ws + WS_WQKV); mode = 5; p0 = 0; }
            else if (r < 640) { item = r - 512; W = P.in[15]; K = DM; N = 256; WT = (bf16_t*)(ws + WS_WQKV); mode = 5; p0 = 1024; }
            else if (r < 768) { item = r - 640; W = P.in[16]; K = DM; N = 256; WT = (bf16_t*)(ws + WS_WQKV); p0 = 1280; }
            else { item = r - 768; W = P.in[19]; K = DM; N = DM; WT = (bf16_t*)(ws + WS_WGO); } }
        else { int r = it - N2;
            if (r < 384) { item = r; W = P.in[20]; K = DM; N = 768; WT = (bf16_t*)(ws + WS_WD); p0 = 0; }
            else if (r < 544) { item = r - 384; W = P.in[23]; K = DM; N = 320; WT = (bf16_t*)(ws + WS_WD); mode = 4; }
            else if (r < 1120) { item = r - 544; W = P.in[22]; K = 768; N = 1536; WT = (bf16_t*)(ws + WS_WUQ); mode = 3; }
            else if (r < 1376) { item = r - 1120; W = P.in[25]; K = 256; N = 2048; WT = (bf16_t*)(ws + WS_WUKV); }
            else { item = r - 1376; W = P.in[26]; K = DM; N = DM; WT = (bf16_t*)(ws + WS_WMO); } }
        transpose_item(W, K, N, WT, mode, p0, scr, item, lane);
    }
}

DI void prologue_phase(const Params& P, LAS unsigned char* lds, int G) {
    const int tid = otid(), lane = tid & 63, wave = tid >> 6;
    unsigned char* ws = P.ws;
    {
        LAS float* sc = (LAS float*)lds; LAS float* red = sc + 9 * DM;
        for (int i = tid; i < 9 * DM; i += NTHREADS) { const int r = i >> 10, k = i & 1023; const float v = r < 8 ? P.in[1][r * DM + k] : P.in[3][k]; sc[i] = v / (1.f + __expf(-v)); }
        __syncthreads();
        float* MOD = (float*)(ws + WS_MOD);
        for (int item = blockIdx.x; item < 4 * 48; item += G) {
            const int l = item / 48, n0 = (item - l * 48) * 128, ks = tid >> 5, cq = tid & 31;
            const float* Wp = P.in[4] + ((size_t)l * DM + ks * 64) * NMOD + n0 + 4 * cq;
            f32x4 a[9];
#pragma unroll
            for (int r = 0; r < 9; ++r) a[r] = (f32x4){0.f, 0.f, 0.f, 0.f};
            const LAS float* s = sc + ks * 64;
#pragma unroll 2
            for (int k4 = 0; k4 < 64; k4 += 4) {
                f32x4 w[4];
#pragma unroll
                for (int q = 0; q < 4; ++q) w[q] = __builtin_nontemporal_load((const f32x4*)(Wp + (size_t)(k4 + q) * NMOD));
#pragma unroll
                for (int r = 0; r < 9; ++r) { const f32x4 sv = *(const LAS f32x4*)(s + r * DM + k4);
                    a[r] += w[0] * sv.x; a[r] += w[1] * sv.y; a[r] += w[2] * sv.z; a[r] += w[3] * sv.w; } }
#pragma unroll
            for (int r = 0; r < 9; ++r) *(LAS f32x4*)(red + (ks * 9 + r) * 128 + 4 * cq) = a[r];
            __syncthreads();
            for (int o = tid; o < 9 * 128; o += NTHREADS) { const int r = o >> 7, c2 = o & 127; float sum = 0.f;
#pragma unroll
                for (int q = 0; q < 16; ++q) sum += red[(q * 9 + r) * 128 + c2];
                MOD[((size_t)l * 9 + r) * NMOD + n0 + c2] = sum + P.in[5][l * NMOD + n0 + c2]; }
            __syncthreads();
        }
    }
    {
        float* gc = (float*)(ws + WS_RGC); float* gs = (float*)(ws + WS_RGS); float* mc = (float*)(ws + WS_RMC); float* ms = (float*)(ws + WS_RMS);
        const int gt = blockIdx.x * NTHREADS + tid, NT_ = G * NTHREADS;
        for (int i = gt; i < SEQ * 96; i += NT_) {
            const int pos = i / 96, a = i - pos * 96; const float row = (float)(pos >> 6), col = (float)(pos & 63);
            if (a < 64) { const int fi = a & 31; const float fr = powf(10000.f, -(float)fi / 32.f); const float ang = (a < 32 ? row : col) * fr;
                gc[pos * 64 + a] = cosf(ang); gs[pos * 64 + a] = sinf(ang); }
            else { const int a2 = a - 64, fi = a2 & 15; const float fr = powf(10000.f, -(float)fi / 16.f); const float ang = (a2 < 16 ? row : col) * fr;
                mc[pos * 32 + a2] = cosf(ang); ms[pos * 32 + a2] = sinf(ang); }
        }
        { u32x4* zs = (u32x4*)(ws + WS_SS); for (int i = gt; i < 10 * T / 4; i += NT_) zs[i] = (u32x4){0u, 0u, 0u, 0u}; }
        { u32x4* z1 = (u32x4*)(ws + WS_WD + (size_t)1056 * DM * 2); u32x4* z2 = (u32x4*)(ws + WS_WD + (size_t)1184 * DM * 2);
          for (int i = gt; i < 96 * DM * 2 / 16; i += NT_) { z1[i] = (u32x4){0u, 0u, 0u, 0u}; z2[i] = (u32x4){0u, 0u, 0u, 0u}; } }
    }
    transposes_items(P, lds, 0, 6272, blockIdx.x * NWAVES + wave, G * NWAVES, 0, lane);
    transposes_items(P, lds, 0, 17888, blockIdx.x * NWAVES + wave, G * NWAVES, 1, lane);
}

DI void prenorm_phase(const float* XL, const float* XC, const float* g, const float* scv, bf16_t* XS, float* SS, int G) {
    const int tid = otid(), lane = tid & 63, gw = blockIdx.x * NWAVES + (tid >> 6), NGW = G * NWAVES;
    for (int r0 = gw; r0 < T; r0 += 3 * NGW) {
        const float* xr[3]; int mi[3], rr[3]; bool ok[3];
#pragma unroll
        for (int q = 0; q < 3; ++q) { const int r = r0 + q * NGW; ok[q] = r < T; rr[q] = ok[q] ? r : r0;
            const int b = rr[q] / RPB, w = rr[q] - b * RPB;
            if (w < CTXL) { xr[q] = XC + (size_t)(b * CTXL + w) * DM; mi[q] = 8; } else { xr[q] = XL + (size_t)(b * SEQ + w - CTXL) * DM; mi[q] = b; } }
        f32x4 v[3][4]; float ss[3];
#pragma unroll
        for (int q = 0; q < 3; ++q)
#pragma unroll
            for (int j = 0; j < 4; ++j) v[q][j] = ((const f32x4*)xr[q])[lane + 64 * j];
#pragma unroll
        for (int q = 0; q < 3; ++q) { float a = 0.f;
#pragma unroll
            for (int j = 0; j < 4; ++j) a += (v[q][j].x * v[q][j].x + v[q][j].y * v[q][j].y) + (v[q][j].z * v[q][j].z + v[q][j].w * v[q][j].w);
            ss[q] = a; }
#pragma unroll
        for (int o = 1; o < 64; o <<= 1)
#pragma unroll
            for (int q = 0; q < 3; ++q) ss[q] += __shfl_xor(ss[q], o);
#pragma unroll
        for (int q = 0; q < 3; ++q) if (ok[q]) {
            if (lane == 0) SS[rr[q]] = ss[q];
#pragma unroll
            for (int j = 0; j < 4; ++j) { const int col = 4 * (lane + 64 * j);
                const f32x4 gv = *(const f32x4*)(g + col), sc = *(const f32x4*)(scv + (size_t)mi[q] * NMOD + col);
                const f32x4 o = v[q][j] * gv * (sc + 1.0f);
                u32x2 w2; w2.x = pk2(o.x, o.y); w2.y = pk2(o.z, o.w);
                *(u32x2*)(XS + (size_t)rr[q] * DM + col) = w2; } }
    }
}
DI void ctxfix_phase(const float* XCsrc, float* XC, const float* slab, const float* gate, const float* g, const float* scv, bf16_t* XS, float* SS, int G) {
    const int tid = otid(), lane = tid & 63, gw = blockIdx.x * NWAVES + (tid >> 6), NGW = G * NWAVES;
    for (int rc = gw; rc < NB * CTXL; rc += NGW) {
        const int b = rc >> 8, w = rc & 255, r = b * RPB + w; float* xr = XC + (size_t)rc * DM; const float* xs_ = XCsrc + (size_t)rc * DM;
        f32x4 v[4]; float ss = 0.f;
#pragma unroll
        for (int j = 0; j < 4; ++j) {
            const float* sp = slab + (size_t)((b * 4 + j) * 4) * 65536 + (size_t)w * 256 + 4 * lane;
            const f32x4 p0 = *(const f32x4*)sp, p1 = *(const f32x4*)(sp + 65536), p2 = *(const f32x4*)(sp + 2 * 65536), p3 = *(const f32x4*)(sp + 3 * 65536);
            const f32x4 x0 = ((const f32x4*)xs_)[lane + 64 * j], gt4 = *(const f32x4*)(gate + (size_t)8 * NMOD + 4 * (lane + 64 * j));
            v[j] = x0 + gt4 * ((p0 + p1) + (p2 + p3));
            ss += (v[j].x * v[j].x + v[j].y * v[j].y) + (v[j].z * v[j].z + v[j].w * v[j].w); }
        ss = wave_sum(ss); if (lane == 0) SS[r] = ss;
#pragma unroll
        for (int j = 0; j < 4; ++j) { const int col = 4 * (lane + 64 * j);
            ((f32x4*)xr)[lane + 64 * j] = v[j];
            const f32x4 gv = *(const f32x4*)(g + col), sc = *(const f32x4*)(scv + (size_t)8 * NMOD + col);
            const f32x4 o = v[j] * gv * (sc + 1.0f);
            u32x2 w2; w2.x = pk2(o.x, o.y); w2.y = pk2(o.z, o.w);
            *(u32x2*)(XS + (size_t)r * DM + col) = w2; }
    }
}
DI void shw_phase(unsigned char* ws, LAS unsigned char* lds, int first, int stride, int set, int lo, int hi) {
    const int tid = otid(), lane = tid & 63, w = tid >> 6;
    const float* MOD = (const float*)(ws + WS_MOD);
    LAS float* shl = (LAS float*)lds; LAS float* red = shl + 9 * DM;
    int cur = -1;
    for (int it = lo + first; it < hi; it += stride) {
        const bf16_t* Wt; const float* sh; float* out; int N, c, cid;
        if (!set) {
            if (it < 48) { cid = 0; c = it; Wt = (const bf16_t*)(ws + WS_WCI); sh = MOD; out = (float*)(ws + WS_SHWI); N = 3072; }
            else { cid = 4; c = it - 48; Wt = (const bf16_t*)(ws + WS_WUP); sh = MOD + 3 * DM; out = (float*)(ws + WS_SHWU); N = 5632; }
        } else {
            if (it < 24) { cid = 1; c = it; Wt = (const bf16_t*)(ws + WS_WQKV); sh = MOD + (size_t)1 * 9 * NMOD; out = (float*)(ws + WS_SHWI) + 1 * 9 * 3072; N = 1536; }
            else if (it < 44) { cid = 2; c = it - 24; Wt = (const bf16_t*)(ws + WS_WD); sh = MOD + (size_t)2 * 9 * NMOD; out = (float*)(ws + WS_SHWI) + 2 * 9 * 3072; N = 1280; }
            else if (it < 92) { cid = 3; c = it - 44; Wt = (const bf16_t*)(ws + WS_WCI + SZ_WCI); sh = MOD + (size_t)3 * 9 * NMOD; out = (float*)(ws + WS_SHWI) + 3 * 9 * 3072; N = 3072; }
            else { const int q = it - 92, l = 1 + q / 88; cid = 4 + l; c = q - (l - 1) * 88; Wt = (const bf16_t*)(ws + WS_WUP + l * SZ_WUP); sh = MOD + (size_t)l * 9 * NMOD + 3 * DM; out = (float*)(ws + WS_SHWU) + (size_t)l * 9 * 5632; N = 5632; }
        }
        if (cid != cur) { __syncthreads(); for (int i = tid; i < 9 * DM; i += NTHREADS) shl[i] = sh[(size_t)(i >> 10) * NMOD + (i & 1023)]; cur = cid; __syncthreads(); }
        const u32x4* wp = (const u32x4*)(Wt + (size_t)(c * 64 + lane) * DM + 128 * w);
        float a[9];
#pragma unroll
        for (int mi = 0; mi < 9; ++mi) a[mi] = 0.f;
#pragma unroll 4
        for (int ch = 0; ch < 16; ++ch) { const u32x4 wv = wp[ch];
            const float e0 = bflo(wv.x), e1 = bfhi(wv.x), e2 = bflo(wv.y), e3 = bfhi(wv.y), e4 = bflo(wv.z), e5 = bfhi(wv.z), e6 = bflo(wv.w), e7 = bfhi(wv.w);
#pragma unroll
            for (int mi = 0; mi < 9; ++mi) { const LAS f32x4* sp = (const LAS f32x4*)(shl + mi * DM + 128 * w + 8 * ch); const f32x4 s0 = sp[0], s1 = sp[1];
                a[mi] += (s0.x * e0 + s0.y * e1) + (s0.z * e2 + s0.w * e3) + (s1.x * e4 + s1.y * e5) + (s1.z * e6 + s1.w * e7); } }
#pragma unroll
        for (int mi = 0; mi < 9; ++mi) red[(w * 9 + mi) * 64 + lane] = a[mi];
        __syncthreads();
        for (int o = tid; o < 9 * 64; o += NTHREADS) { const int mi = o >> 6, c2 = o & 63; float sum = 0.f;
#pragma unroll
            for (int q = 0; q < 8; ++q) sum += red[(q * 9 + mi) * 64 + c2];
            out[(size_t)mi * N + c * 64 + c2] = sum; }
        __syncthreads();
    }
}

DI void conv_phase(const bf16_t* __restrict__ BUF1, const float* __restrict__ cw, bf16_t* __restrict__ H, bool latonly, int G) {
    const int gt = blockIdx.x * NTHREADS + otid(), NT_ = G * NTHREADS;
    if ((NT_ & 127) == 0) {
        const int c8 = (gt & 127) * 8, rstep = NT_ >> 7;
        float w0[8], w1[8], w2[8];
#pragma unroll
        for (int q = 0; q < 8; ++q) { w0[q] = cw[c8 + q]; w1[q] = cw[DM + c8 + q]; w2[q] = cw[2 * DM + c8 + q]; }
#pragma unroll 3
        for (int r = gt >> 7; r < T; r += rstep) {
            const int b = r / RPB, w = r - b * RPB;
            if (latonly && w < CTXL) continue;
            const bool hp = !(w == 0 || w == CTXL), hn = !(w == CTXL - 1 || w == RPB - 1);
            const bf16_t* up = BUF1 + (size_t)r * 2048 + 1024 + c8;
            const u32x4 zero = {0u, 0u, 0u, 0u};
            const u32x4 uc = *(const u32x4*)up, um = hp ? *(const u32x4*)(up - 2048) : zero, un = hn ? *(const u32x4*)(up + 2048) : zero;
            const u32x4 bb = *(const u32x4*)(BUF1 + (size_t)r * 2048 + c8);
            u32x4 o;
#pragma unroll
            for (int q = 0; q < 4; ++q) {
                const float z0 = bflo(um[q]) * w0[2 * q] + bflo(uc[q]) * w1[2 * q] + bflo(un[q]) * w2[2 * q];
                const float z1 = bfhi(um[q]) * w0[2 * q + 1] + bfhi(uc[q]) * w1[2 * q + 1] + bfhi(un[q]) * w2[2 * q + 1];
                o[q] = pk2(bflo(bb[q]) * z0, bfhi(bb[q]) * z1);
            }
            *(u32x4*)(H + (size_t)r * DM + c8) = o;
        }
        return;
    }
    for (int idx = gt; idx < T * 128; idx += NT_) {
        const int r = idx >> 7, c8 = (idx & 127) * 8; const int b = r / RPB, w = r - b * RPB;
        if (latonly && w < CTXL) continue;
        const bool hp = !(w == 0 || w == CTXL), hn = !(w == CTXL - 1 || w == RPB - 1);
        const bf16_t* up = BUF1 + (size_t)r * 2048 + 1024 + c8;
        const u32x4 zero = {0u, 0u, 0u, 0u};
        const u32x4 uc = *(const u32x4*)up, um = hp ? *(const u32x4*)(up - 2048) : zero, un = hn ? *(const u32x4*)(up + 2048) : zero;
        const u32x4 bb = *(const u32x4*)(BUF1 + (size_t)r * 2048 + c8);
        u32x4 o;
#pragma unroll
        for (int q = 0; q < 4; ++q) {
            const int ch = c8 + 2 * q;
            const float z0 = bflo(um[q]) * cw[ch] + bflo(uc[q]) * cw[DM + ch] + bflo(un[q]) * cw[2 * DM + ch];
            const float z1 = bfhi(um[q]) * cw[ch + 1] + bfhi(uc[q]) * cw[DM + ch + 1] + bfhi(un[q]) * cw[2 * DM + ch + 1];
            o[q] = pk2(bflo(bb[q]) * z0, bfhi(bb[q]) * z1);
        }
        *(u32x4*)(H + (size_t)r * DM + c8) = o;
    }
}

DI void gqa_qknorm_phase(bf16_t* QKV, const float* qg, const float* kg, const float* cosT, const float* sinT, int G) {
    const int tid = otid(), lane = tid & 63, gw = blockIdx.x * NWAVES + (tid >> 6), NGW = G * NWAVES;
    for (int r = gw; r < T; r += NGW) {
        const int b = r / RPB, w = r - b * RPB; const bool lat = w >= CTXL; const int pos = w - CTXL;
        const float c = lat ? cosT[pos * 64 + lane] : 1.f, s = lat ? sinT[pos * 64 + lane] : 0.f;
        bf16_t* p = QKV + (size_t)r * 1536;
        float x1[10], x2[10], sq[10];
#pragma unroll
        for (int hh = 0; hh < 10; ++hh) { x1[hh] = bf2f(p[hh * 128 + lane]); x2[hh] = bf2f(p[hh * 128 + 64 + lane]); }
#pragma unroll
        for (int hh = 0; hh < 10; ++hh) sq[hh] = x1[hh] * x1[hh] + x2[hh] * x2[hh];
#pragma unroll
        for (int o = 1; o < 64; o <<= 1)
#pragma unroll
            for (int hh = 0; hh < 10; ++hh) sq[hh] += __shfl_xor(sq[hh], o);
        const float qg1 = qg[lane], qg2 = qg[64 + lane], kg1 = kg[lane], kg2 = kg[64 + lane];
#pragma unroll
        for (int hh = 0; hh < 10; ++hh) {
            const float rstd = 1.0f / sqrtf(sq[hh] * (1.f / 128.f) + EPS);
            const float y1 = x1[hh] * rstd * (hh < 8 ? qg1 : kg1), y2 = x2[hh] * rstd * (hh < 8 ? qg2 : kg2);
            p[hh * 128 + lane] = (bf16_t)f2bf(y1 * c - y2 * s); p[hh * 128 + 64 + lane] = (bf16_t)f2bf(y1 * s + y2 * c);
        }
    }
}

DI void mla_norm_phase(const float* C1, const float* qg, const float* kvg, const float* cosT, const float* sinT, bf16_t* CQ, bf16_t* CKV, bf16_t* KPE, int G) {
    const int tid = otid(), lane = tid & 63, gw = blockIdx.x * NWAVES + (tid >> 6), NGW = G * NWAVES;
    for (int r = gw; r < T; r += NGW) {
        const int b = r / RPB, w = r - b * RPB; const bool lat = w >= CTXL; const int pos = w - CTXL;
        const float* cr = C1 + (size_t)r * 1280;
        f32x4 v[3]; float ss = 0.f;
#pragma unroll
        for (int j = 0; j < 3; ++j) { v[j] = ((const f32x4*)cr)[lane + 64 * j]; ss += (v[j].x * v[j].x + v[j].y * v[j].y) + (v[j].z * v[j].z + v[j].w * v[j].w); }
        const float rq = 1.0f / sqrtf(wave_sum(ss) * (1.f / 768.f) + EPS);
#pragma unroll
        for (int j = 0; j < 3; ++j) { const int col = 4 * (lane + 64 * j); const f32x4 gv = *(const f32x4*)(qg + col); const f32x4 o = v[j] * rq * gv;
            u32x2 w2; w2.x = pk2(o.x, o.y); w2.y = pk2(o.z, o.w); *(u32x2*)(CQ + (size_t)r * 768 + col) = w2; }
        const f32x4 kv = ((const f32x4*)(cr + 768))[lane];
        const float rk = 1.0f / sqrtf(wave_sum((kv.x * kv.x + kv.y * kv.y) + (kv.z * kv.z + kv.w * kv.w)) * (1.f / 256.f) + EPS);
        { const f32x4 gv = *(const f32x4*)(kvg + 4 * lane); const f32x4 o = kv * rk * gv;
          u32x2 w2; w2.x = pk2(o.x, o.y); w2.y = pk2(o.z, o.w); *(u32x2*)(CKV + (size_t)r * 256 + 4 * lane) = w2; }
        if (lane < 32) { const float x1 = cr[1024 + lane], x2 = cr[1056 + lane];
            const float c = lat ? cosT[pos * 32 + lane] : 1.f, s = lat ? sinT[pos * 32 + lane] : 0.f;
            KPE[(size_t)r * 64 + lane] = (bf16_t)f2bf(x1 * c - x2 * s); KPE[(size_t)r * 64 + 32 + lane] = (bf16_t)f2bf(x1 * s + x2 * c); }
    }
}

template <int DQK, int LDQ, int LDK, int SDEPTH>
DI void attn_phase(const bf16_t* Q, int qhs, const bf16_t* Kb, const bf16_t* Vb, int khs, int kdiv, const bf16_t* KPE, bf16_t* O, char* lds, int G, int nunits, int vc) {
    for (int u = vc; u < nunits; u += G) {
        int b, h, qrow, nk;
        if (u < 512) { h = u & 7; const int qb = (u >> 3) & 7; b = u >> 6; qrow = b * RPB + CTXL + qb * 256; nk = RPB; }
        else { const int uc = u - 512; h = uc & 7; b = uc >> 3; qrow = b * RPB; nk = CTXL; }
        const int kvh = h / kdiv; const size_t krow = (size_t)b * RPB;
        att::attn_body<DQK, LDQ, LDK, SDEPTH>(Q + (size_t)qrow * LDQ + h * qhs, Kb + krow * LDK + kvh * khs, Vb + krow * LDK + kvh * khs, KPE + krow * 64,
                                               O + (size_t)qrow * DM + h * 128, nk, lds);
        __syncthreads();
    }
}

#define XB_TMO      128
#define XB_XCNT(j)  (256  + 64 * (j))
#define XB_XSUB(j)  (1280 + 64 * (j))
#define XB_XGEN(j)  (2304 + 64 * (j))
#define XB_TOP      3328
#define XB_TOPGEN   3392
#define XCD_BAR_WORDS 3456
#define XB_SPIN_CAP (1u << 20)
DI unsigned xb_ld(unsigned* p)              { return __hip_atomic_load(p, __ATOMIC_RELAXED, __HIP_MEMORY_SCOPE_AGENT); }
DI unsigned xb_add(unsigned* p, unsigned v) { return __hip_atomic_fetch_add(p, v, __ATOMIC_RELAXED, __HIP_MEMORY_SCOPE_AGENT); }
DI unsigned xb_xcc_id() { return (unsigned)__builtin_amdgcn_s_getreg((3 << 11) | 20) & 0xFu; }
#define XB_SPIN(cond, bar) do { unsigned _sp = 0; while (cond) { __builtin_amdgcn_s_sleep(1); \
    if ((++_sp & 255u) == 0u) { if (xb_ld(&(bar)[XB_TMO])) break; if (_sp > XB_SPIN_CAP) { atomicAdd(&(bar)[XB_TMO], 1u); break; } } } } while (0)
struct XcdBarrier { unsigned* bar; unsigned x; volatile LAS unsigned* st; };
DI XcdBarrier xcd_barrier_post(unsigned* bar, volatile LAS unsigned* st) {
    XcdBarrier b; b.bar = bar; b.x = 0u; b.st = st;
    if (threadIdx.x == 0) { const unsigned x = xb_xcc_id(); st[2] = x; st[3] = xb_add(&bar[XB_XCNT(x)], 1u); }
    return b;
}
DI void xcd_barrier_complete(unsigned* bar, unsigned x, unsigned& nloc, unsigned& nx) {
    const unsigned G = gridDim.x * gridDim.y * gridDim.z;
    unsigned sum, cnt, mine, sp = 0u;
    for (;;) {
        sum = 0u; cnt = 0u; mine = 0u;
#pragma unroll
        for (unsigned j = 0; j < 16; ++j) { const unsigned c = xb_ld(&bar[XB_XCNT(j)]); sum += c; cnt += (c > 0u) ? 1u : 0u; mine = (j == x) ? c : mine; }
        if (sum == G) break;
        __builtin_amdgcn_s_sleep(1);
        if ((++sp & 255u) == 0u) { if (xb_ld(&bar[XB_TMO])) break; if (sp > XB_SPIN_CAP) { atomicAdd(&bar[XB_TMO], 1u); break; } }
    }
    nloc = mine > 0u ? mine : 1u; nx = cnt > 0u ? cnt : 1u;
}
DI void xcd_barrier(const XcdBarrier& b) {
    asm volatile("s_waitcnt vmcnt(0)" ::: "memory");
    __syncthreads();
    if (threadIdx.x == 0) {
        unsigned* bar = b.bar; asm volatile("" : "+s"(bar));
        __builtin_amdgcn_s_waitcnt(0);
        unsigned nloc = b.st[0], nx = b.st[1]; const unsigned bx = b.st[2];
        if (nloc == 0u) { xcd_barrier_complete(bar, bx, nloc, nx); b.st[0] = nloc; b.st[1] = nx; }
        const unsigned old = xb_add(&bar[XB_XSUB(bx)], 1u);
        const unsigned gen = old / nloc;
        if (old + 1u == (gen + 1u) * nloc) {
            __builtin_amdgcn_fence(__ATOMIC_RELEASE, "agent");
            asm volatile("s_waitcnt vmcnt(0)" ::: "memory");
            const unsigned og = xb_add(&bar[XB_TOP], 1u);
            const unsigned tg = og / nx;
            if (og + 1u == (tg + 1u) * nx) xb_add(&bar[XB_TOPGEN], 1u);
            else XB_SPIN(xb_ld(&bar[XB_TOPGEN]) == tg, bar);
            __builtin_amdgcn_fence(__ATOMIC_ACQUIRE, "agent");
            xb_add(&bar[XB_XGEN(bx)], 1u);
            asm volatile("s_waitcnt vmcnt(0)" ::: "memory");
        } else {
            XB_SPIN(xb_ld(&bar[XB_XGEN(bx)]) == gen, bar);
            __builtin_amdgcn_fence(__ATOMIC_ACQUIRE, "agent");
            asm volatile("s_waitcnt vmcnt(0)" ::: "memory");
        }
    }
    __syncthreads();
}

__global__ void __launch_bounds__(NTHREADS, 2) fwd_megakernel(Params P) {
    extern __shared__ __attribute__((aligned(16))) unsigned char lds_raw[];
    cg::grid_group grid = cg::this_grid();
    LAS unsigned char* lds = (LAS unsigned char*)lds_raw;
    const int G = gridDim.x;
    unsigned char* ws = P.ws;
    volatile LAS unsigned* MISC = (volatile LAS unsigned*)(lds + 131072);
    if (threadIdx.x < 16) MISC[threadIdx.x] = 0u;
    __syncthreads();
    const XcdBarrier xbar = xcd_barrier_post((unsigned*)(ws + WS_CTL), MISC + 8);
#define GRID_SYNC() xcd_barrier(xbar)
    float* XL = P.out; float* XC = (float*)(ws + WS_XC);
    const float* MOD = (const float*)(ws + WS_MOD);
    bf16_t* H = (bf16_t*)(ws + WS_H); bf16_t* BUF1 = (bf16_t*)(ws + WS_BUF1); bf16_t* ACT = (bf16_t*)(ws + WS_ACT);

    bf16_t* XS = (bf16_t*)(ws + WS_XS); float* SS = (float*)(ws + WS_SS);
    prologue_phase(P, lds, G);
    if (G > 65535) grid.sync();
    GRID_SYNC();
    if (threadIdx.x == 0) {
        unsigned* barw = (unsigned*)(ws + WS_CTL); const unsigned myx = MISC[10], rank = MISC[11]; unsigned v = 0u;
        for (unsigned jx = 0; jx < 16; ++jx) { const unsigned c = xb_ld(&barw[XB_XCNT(jx)]); v += (c < rank ? c : rank) + ((jx < myx && c > rank) ? 1u : 0u); }
        MISC[12] = v;
    }
    __syncthreads();
    const int vc = __builtin_amdgcn_readfirstlane((int)MISC[12]);
    prenorm_phase(P.in[0], P.in[2], P.in[6], MOD + 1 * DM, XS, SS, G);
    shw_phase(ws, lds, blockIdx.x, G, 0, 0, 136); shw_phase(ws, lds, blockIdx.x, G, 1, 0, 356);
    GRID_SYNC();

    for (int L = 0; L < 4; ++L) {
        const int kind = L % 3, j = L / 3; const bool latonly = (L == 3);
        const bool latout = (L >= 2);
        const float* srcL = (L == 0) ? P.in[0] : XL; const float* srcC = (L == 0) ? P.in[2] : XC;
        const float* modL = MOD + (size_t)L * 9 * NMOD;
        const float* ssA = SS + (size_t)(2 * L) * T; const float* ssB = SS + (size_t)(2 * L + 1) * T;
        const float* shwI = (const float*)(ws + WS_SHWI) + (size_t)L * 9 * 3072; const float* shwU = (const float*)(ws + WS_SHWU) + (size_t)L * 9 * 5632;
        const bf16_t* Wout;
        if (kind == 0) {
            { pg8::Gemm g{XS, (const bf16_t*)(ws + WS_WCI + j * SZ_WCI), DM, DM}; pg8::Sched S; S.init(latonly, 3072, G, vc);
              pg8::Epi<pg8::EK_CONVIN> E{}; E.O = BUF1; E.ldc = 2048; E.ss = ssA; E.shw = shwI; E.shwN = 3072;
              pg8::gemm_phase(lds, g, S, E); }
            GRID_SYNC();
            conv_phase(BUF1, P.in[12] + (size_t)j * 3 * DM, H, latonly, G);
            GRID_SYNC();
            Wout = (const bf16_t*)(ws + WS_WCO + j * SZ_WSQ);
        } else if (kind == 1) {
            { pg8::Gemm g{XS, (const bf16_t*)(ws + WS_WQKV), DM, DM}; pg8::Sched S; S.init(0, 1536, G, vc);
              pg8::Epi<pg8::EK_QKV> E{}; E.O = BUF1; E.ldc = 1536; E.ss = ssA; E.shw = shwI; E.shwN = 1536; E.g1 = P.in[17]; E.g2 = P.in[18];
              E.cosT = (const float*)(ws + WS_RGC); E.sinT = (const float*)(ws + WS_RGS); E.xlds = lds + 131072 + 4096;
              pg8::gemm_phase(lds, g, S, E); }
            GRID_SYNC();
            attn_phase<128, 1536, 1536, 2>(BUF1, 128, BUF1 + 1024, BUF1 + 1280, 128, 4, BUF1, H, (char*)lds_raw, G, 576, vc);
            GRID_SYNC();
            Wout = (const bf16_t*)(ws + WS_WGO);
        } else {
            bf16_t* QM = (bf16_t*)(ws + WS_ACT);
            bf16_t* CQ = QM + (size_t)T * 1536; bf16_t* CKV = CQ + (size_t)T * 768; bf16_t* KPE = (bf16_t*)(ws + WS_KPE);
            float* SSQ = SS + (size_t)8 * T; float* SSKV = SS + (size_t)9 * T;
            { pg8::Gemm g{XS, (const bf16_t*)(ws + WS_WD), DM, DM}; pg8::Sched S; S.init(0, 1280, G, vc);
              pg8::Epi<pg8::EK_MLAD> E{}; E.O = CQ; E.O2 = CKV; E.O3 = KPE; E.g1 = P.in[21]; E.g2 = P.in[24]; E.ssa = SSQ; E.ssb = SSKV;
              E.cosT = (const float*)(ws + WS_RMC); E.sinT = (const float*)(ws + WS_RMS); E.ss = ssA; E.shw = shwI; E.shwN = 1280;
              pg8::gemm_phase(lds, g, S, E); }
            GRID_SYNC();
            { pg8::Gemm g{CQ, (const bf16_t*)(ws + WS_WUQ), 768, 768}; pg8::Sched S; S.init(1, 1536, G, vc, 768);
              pg8::Epi<pg8::EK_MLAQ> E{}; E.O = QM; E.ldc = 1536; E.cosT = (const float*)(ws + WS_RMC); E.sinT = (const float*)(ws + WS_RMS); E.ss = SSQ; E.inv_n = 1.f / 768.f;
              pg8::gemm_phase(lds, g, S, E); }
            { pg8::Gemm g{CKV, (const bf16_t*)(ws + WS_WUKV), 256, 256}; pg8::Sched S; S.init(0, 2048, G, vc, 256, 1);
              pg8::Epi<pg8::EK_BF16> E{}; E.O = BUF1; E.ldc = 2048; E.ss = SSKV; E.inv_n = 1.f / 256.f;
              pg8::gemm_phase(lds, g, S, E); }
            GRID_SYNC();
            attn_phase<192, 1536, 2048, 1>(QM, 192, BUF1, BUF1 + 128, 256, 1, KPE, H, (char*)lds_raw, G, 512, vc);
            GRID_SYNC();
            Wout = (const bf16_t*)(ws + WS_WMO);
        }
        const bool splitk = !latout && G == 256;
        { pg8::Gemm g{H, Wout, DM, DM};
          pg8::Epi<pg8::EK_RESID> E{}; E.srcL = srcL; E.srcC = srcC; E.dstL = XL; E.dstC = XC; E.gate = modL + 2 * DM; E.slab = (float*)BUF1;
          E.gnext = P.in[7] + L * DM; E.scnext = modL + 4 * DM; E.ssnext = SS + (size_t)(2 * L + 1) * T; E.XS = XS;
          pg8::Sched S; S.init(latout, DM, G, vc, DM, 0, splitk); pg8::gemm_phase(lds, g, S, E); }
        GRID_SYNC();
        if (splitk) {
            ctxfix_phase(srcC, XC, (const float*)BUF1, modL + 2 * DM, P.in[7] + L * DM, modL + 4 * DM, XS, SS + (size_t)(2 * L + 1) * T, G);
            GRID_SYNC();
        }
        { pg8::Gemm g{XS, (const bf16_t*)(ws + WS_WUP + L * SZ_WUP), DM, DM}; pg8::Sched S; S.init(latout, 2 * FF, G, vc);
          pg8::Epi<pg8::EK_SWIGLU> E{}; E.O = ACT; E.ldc = FF; E.ss = ssB; E.shw = shwU; E.shwN = 5632;
          pg8::gemm_phase(lds, g, S, E); }
        GRID_SYNC();
        { pg8::Gemm g{ACT, (const bf16_t*)(ws + WS_WDN + L * SZ_WDN), FF, FF};
          pg8::Epi<pg8::EK_RESID> E{}; E.srcL = XL; E.srcC = XC; E.dstL = XL; E.dstC = XC; E.gate = modL + 5 * DM; E.slab = (float*)BUF1;
          if (L < 3) { E.gnext = P.in[6] + (L + 1) * DM; E.scnext = MOD + (size_t)(L + 1) * 9 * NMOD + 1 * DM; E.ssnext = SS + (size_t)(2 * L + 2) * T; E.XS = XS; }
          pg8::Sched S; S.init(latout, DM, G, vc, FF, 0, splitk); pg8::gemm_phase(lds, g, S, E); }
        GRID_SYNC();
        if (splitk) {
            ctxfix_phase(XC, XC, (const float*)BUF1, modL + 5 * DM, P.in[6] + (L + 1) * DM, MOD + (size_t)(L + 1) * 9 * NMOD + 1 * DM, XS, SS + (size_t)(2 * L + 2) * T, G);
            GRID_SYNC();
        }
    }
    const int ftid = otid(), lane = ftid & 63, gw = blockIdx.x * NWAVES + (ftid >> 6), NGW = G * NWAVES;
    for (int r = gw; r < NB * SEQ; r += 2 * NGW) {
        const int r2 = r + NGW; const bool has2 = r2 < NB * SEQ;
        float* xr = XL + (size_t)r * DM; float* xr2 = XL + (size_t)(has2 ? r2 : r) * DM; f32x4 v[4], v2[4]; float ss = 0.f, ss2 = 0.f;
#pragma unroll
        for (int q = 0; q < 4; ++q) { v[q] = ((const f32x4*)xr)[lane + 64 * q]; v2[q] = ((const f32x4*)xr2)[lane + 64 * q]; }
#pragma unroll
        for (int q = 0; q < 4; ++q) { ss += (v[q].x * v[q].x + v[q].y * v[q].y) + (v[q].z * v[q].z + v[q].w * v[q].w); ss2 += (v2[q].x * v2[q].x + v2[q].y * v2[q].y) + (v2[q].z * v2[q].z + v2[q].w * v2[q].w); }
#pragma unroll
        for (int o = 1; o < 64; o <<= 1) { ss += __shfl_xor(ss, o); ss2 += __shfl_xor(ss2, o); }
        const float rstd = 1.0f / sqrtf(ss * (1.f / DM) + EPS), rstd2 = 1.0f / sqrtf(ss2 * (1.f / DM) + EPS);
#pragma unroll
        for (int q = 0; q < 4; ++q) { const f32x4 gv = ((const f32x4*)P.in[27])[lane + 64 * q]; ((f32x4*)xr)[lane + 64 * q] = v[q] * rstd * gv; if (has2) ((f32x4*)xr2)[lane + 64 * q] = v2[q] * rstd2 * gv; }
    }
}

extern "C" void kernel_launch(void* const* d_in, const int* in_sizes, int n_in, void* d_out, int out_size, void* d_ws, size_t ws_size, hipStream_t stream) {
    static int grid = 0;
    if (grid == 0) {
        if (n_in != 28 || in_sizes[0] != NB * SEQ * DM || out_size != NB * SEQ * DM || ws_size < WS_END) {
            fprintf(stderr, "kernel_launch: shape/workspace mismatch: n_in %d in0 %d out %d ws %zu (need %zu)\n", n_in, n_in > 0 ? in_sizes[0] : -1, out_size, ws_size, (size_t)WS_END); grid = -1; return; }
        int dev = 0, cus = 0, per_cu = 0;
        if (hipGetDevice(&dev) != hipSuccess || hipDeviceGetAttribute(&cus, hipDeviceAttributeMultiprocessorCount, dev) != hipSuccess) { grid = -1; return; }
        if (hipFuncSetAttribute((const void*)fwd_megakernel, hipFuncAttributeMaxDynamicSharedMemorySize, LDS_BYTES) != hipSuccess) { fprintf(stderr, "kernel_launch: hipFuncSetAttribute failed\n"); grid = -1; return; }
        if (hipOccupancyMaxActiveBlocksPerMultiprocessor(&per_cu, (const void*)fwd_megakernel, NTHREADS, LDS_BYTES) != hipSuccess || per_cu < 1) { fprintf(stderr, "kernel_launch: occupancy query says %d\n", per_cu); per_cu = 1; }
        (void)hipGetLastError();
        grid = cus;
    }
    if (grid < 0) return;
    Params p{};
    for (int i = 0; i < 28; ++i) p.in[i] = (const float*)d_in[i];
    p.out = (float*)d_out; p.ws = (unsigned char*)d_ws;
    if (hipMemsetAsync((char*)d_ws + WS_CTL, 0, CTL_BYTES, stream) != hipSuccess) { fprintf(stderr, "kernel_launch: memset failed\n"); return; }
    void* args[] = {&p};
    hipError_t e = hipLaunchCooperativeKernel((const void*)fwd_megakernel, dim3(grid), dim3(NTHREADS), args, LDS_BYTES, stream);
    if (e != hipSuccess) fprintf(stderr, "kernel_launch: cooperative launch failed: %s (grid %d)\n", hipGetErrorString(e), grid);
}
```

```cpp
#include <hip/hip_runtime.h>
#include <hip/hip_cooperative_groups.h>
#include <cstdio>
#include <cstdint>
namespace cg = cooperative_groups;

#define LAS __attribute__((address_space(3)))
typedef unsigned short bf16_t;
typedef short bf16x8 __attribute__((ext_vector_type(8)));
typedef short s16x4 __attribute__((ext_vector_type(4)));
typedef float f32x4 __attribute__((ext_vector_type(4)));
typedef float f32x16 __attribute__((ext_vector_type(16)));
typedef unsigned u32x4 __attribute__((ext_vector_type(4)));
typedef unsigned u32x2 __attribute__((ext_vector_type(2)));
typedef unsigned long long u64;
#define SSQ_FIX(x) __float2ull_rn((x) * 1048576.f)
#define SSQ_UNFIX(u) ((float)(u) * (1.f / 1048576.f))
#define DI __device__ __forceinline__

constexpr int NB = 8, SEQ = 2048, DM = 1024, CTXL = 256, RPB = SEQ + CTXL  , T = NB * RPB  ;
constexpr int FF = 2816, NMOD = 6 * DM;
constexpr float EPS = 1e-6f;
constexpr int NTHREADS = 512, NWAVES = 8;

constexpr size_t AL(size_t x) { return (x + 255) / 256 * 256; }
constexpr size_t WS_XC = 0;
constexpr size_t WS_MOD = WS_XC + AL((size_t)NB * CTXL * DM * 4);
constexpr size_t WS_RGC = WS_MOD + AL((size_t)4 * 9 * NMOD * 4);
constexpr size_t WS_RGS = WS_RGC + AL((size_t)SEQ * 64 * 4);
constexpr size_t WS_RMC = WS_RGS + AL((size_t)SEQ * 64 * 4);
constexpr size_t WS_RMS = WS_RMC + AL((size_t)SEQ * 32 * 4);
constexpr size_t WS_H = WS_RMS + AL((size_t)SEQ * 32 * 4);
constexpr size_t WS_BUF1 = WS_H + AL((size_t)T * DM * 2);
constexpr size_t WS_ACT = WS_BUF1 + AL((size_t)T * 2048 * 2);
constexpr size_t WS_CQ = WS_ACT + AL((size_t)T * FF * 2);
constexpr size_t WS_CKV = WS_CQ + AL((size_t)T * 768 * 2);
constexpr size_t WS_KPE = WS_CKV + AL((size_t)T * 256 * 2);
constexpr size_t WS_WUP = WS_KPE + AL((size_t)T * 64 * 2);
constexpr size_t SZ_WUP = (size_t)2 * FF * DM * 2;
constexpr size_t WS_WDN = WS_WUP + 4 * SZ_WUP;
constexpr size_t SZ_WDN = (size_t)DM * FF * 2;
constexpr size_t WS_WCI = WS_WDN + 4 * SZ_WDN;
constexpr size_t SZ_WCI = (size_t)3072 * DM * 2;
constexpr size_t WS_WCO = WS_WCI + 2 * SZ_WCI;
constexpr size_t SZ_WSQ = (size_t)DM * DM * 2;
constexpr size_t WS_WQKV = WS_WCO + 2 * SZ_WSQ;
constexpr size_t WS_WGO = WS_WQKV + (size_t)1536 * DM * 2;
constexpr size_t WS_WD = WS_WGO + SZ_WSQ;
constexpr size_t WS_WUQ = WS_WD + (size_t)1280 * DM * 2;
constexpr size_t WS_WUKV = WS_WUQ + (size_t)1536 * 768 * 2;
constexpr size_t WS_WMO = WS_WUKV + (size_t)2048 * 256 * 2;
constexpr size_t WS_SS = WS_WMO + SZ_WSQ;
constexpr size_t WS_SHWI = WS_SS + AL((size_t)10 * T * 8);
constexpr size_t WS_SHWU = WS_SHWI + AL((size_t)4 * 9 * 3072 * 4);
constexpr size_t WS_CTL = WS_SHWU + AL((size_t)4 * 9 * 5632 * 4);
constexpr size_t CTL_BYTES = 16384;
constexpr size_t WS_END = WS_CTL + CTL_BYTES;
static_assert((size_t)T * (1536 + 768 + 256) * 2 <= (size_t)T * FF * 2, "QM | CQ | CKV fit in the FFN hidden buffer");
constexpr size_t WS_XS = WS_CQ;
static_assert(WS_CKV == WS_CQ + (size_t)T * 768 * 2 && WS_KPE == WS_CKV + (size_t)T * 256 * 2, "CQ|CKV contiguous = XS");
static_assert(WS_END <= (size_t)400 * 1000 * 1000, "workspace budget");

constexpr int LDS_BYTES = 131072 + 4096 + 4096;

struct Params { const float* in[28]; float* out; unsigned char* ws; };

DI unsigned f2bf(float f) { unsigned u = __float_as_uint(f); return (u + 0x7fffu + ((u >> 16) & 1u)) >> 16; }
DI unsigned pk2(float lo, float hi) { return f2bf(lo) | (f2bf(hi) << 16); }
DI float bf2f(unsigned short b) { return __uint_as_float(((unsigned)b) << 16); }
DI float bflo(unsigned w) { return __uint_as_float(w << 16); }
DI float bfhi(unsigned w) { return __uint_as_float(w & 0xffff0000u); }
DI unsigned cvt_pk_bf16(float lo, float hi) { unsigned r; asm volatile("v_cvt_pk_bf16_f32 %0, %1, %2" : "=v"(r) : "v"(lo), "v"(hi)); return r; }
DI float wave_sum(float v) {
#pragma unroll
    for (int o = 1; o < 64; o <<= 1) v += __shfl_xor(v, o);
    return v;
}
DI int otid() { int t = threadIdx.x; asm volatile("" : "+v"(t)); return t; }
#define LDS_WAIT() asm volatile("s_waitcnt lgkmcnt(0)" ::: "memory")

namespace pg8 {
constexpr int BM = 256, BK = 64, HALF = 128, HTB = HALF * BK * 2, STAGE_BYTES = 8 * HTB, NXCD = 8, WGM = 8;
DI int lds_byte(int r, int c) { const int st = (r >> 4) * 2 + (c >> 5), rr = r & 15, cc = c & 31, ob = rr * 64 + cc * 2; return st * 1024 + (ob ^ (((ob >> 9) & 1) << 5)); }
DI void stage_rc(int b, int& R, int& C) { const int st = b / 1024, sb = b % 1024, swz = sb ^ (((sb >> 9) & 1) << 5); R = (st >> 1) * 16 + swz / 64; C = (st & 1) * 32 + (swz % 64) / 2; }
DI int perm32(int rho) { const int n = rho >> 4, i = rho & 15; return 8 * (i >> 2) + 4 * n + (i & 3); }

struct Unit { int pm, pn, k0, nt, part; };
struct Gemm { const bf16_t* A; const bf16_t* Bt; int lda, K; };

struct Sched {
    int nM, nN, nwg, G, c, latonly, ntk, skew, split;
    DI void init(int latonly_, int N, int G_, int c_, int K_ = DM, int skew_ = 0, int split_ = 0) { latonly = latonly_; nM = latonly_ ? 64 : 72; nN = N / BM; nwg = nM * nN; G = G_; c = c_; ntk = K_ / BK; skew = skew_; split = split_; }
    DI bool next(int i, Unit& u) const {
        long L = (long)i * G + c;
        if (split) {
            if (L >= 256 + 128) return false;
            if (L < 256) { int wgid = (int)L; { const int q = 256 / NXCD, xcd = wgid % NXCD, off = wgid / NXCD; wgid = xcd * q + off; }
                const int nig = WGM * 4, gid = wgid / nig, fm = gid * WGM; const int pm = fm + ((wgid % nig) % WGM); u.pn = (wgid % nig) / WGM;
                u.pm = (pm >> 3) * 9 + 1 + (pm & 7); u.k0 = 0; u.nt = ntk; u.part = 0; }
            else { const int idx = (int)L - 256, tile = idx >> 2, seg = idx & 3; u.pm = (tile >> 2) * 9; u.pn = tile & 3; u.part = 1 + seg;
                if (ntk == 44) { u.k0 = (seg >> 1) * 22 + (seg & 1) * 12; u.nt = (seg & 1) ? 10 : 12; } else { u.k0 = seg * 4; u.nt = 4; } }
            return true;
        }
        if (skew && G == 256) {
            if (c < 128) { if (i > 0) return false; L = c; } else L = c + 128 * i; }
        if (L >= nwg) return false;
        u.k0 = 0; u.nt = ntk; u.part = 0;
        int wgid = (int)L; { const int q = nwg / NXCD, r = nwg % NXCD, xcd = wgid % NXCD, off = wgid / NXCD; wgid = (xcd < r ? xcd * (q + 1) : r * (q + 1) + (xcd - r) * q) + off; }
        const int nig = WGM * nN, gid = wgid / nig, fm = gid * WGM, gsz = (nM - fm) < WGM ? (nM - fm) : WGM;
        int pm = fm + ((wgid % nig) % gsz); u.pn = (wgid % nig) / gsz;
        u.pm = latonly ? (pm >> 3) * 9 + 1 + (pm & 7) : pm; return true;
    }
    DI void a_ready(const Unit&) const {}
    DI void done(const Unit&) const {}
};

template <class Epi, class SchedT>
DI void gemm_phase(LAS unsigned char* lds, const Gemm g, const SchedT& S, const Epi& E) {
    const int tid = otid(), wid = __builtin_amdgcn_readfirstlane(tid >> 6), lane = tid & 63, wr = wid >> 2, wc = wid & 3, fr = lane & 15, fq = lane >> 4;
    const int K = g.K, lda = g.lda;
    unsigned voffA[2], voffB[2];
#pragma unroll
    for (int i = 0; i < 2; ++i) { int R, C; stage_rc(tid * 16 + i * 8192, R, C); const int Rb = Epi::PERM ? ((R & ~31) + perm32(R & 31)) : R;
        voffA[i] = (unsigned)(R * lda + C) * 2u; voffB[i] = (unsigned)(Rb * K + C) * 2u; }
    const size_t kstep = (size_t)(BK * 2);
    const size_t hstepA = (size_t)HALF * lda * 2, hstepB = (size_t)HALF * K * 2;
    const size_t tstepA = 2 * hstepA, tstepB = 2 * hstepB;
    const unsigned ldsw = (unsigned)wid * 1024u;
    const int aoff = lds_byte(wr * 64 + fr, fq * 8), boff = lds_byte(wc * 32 + fr, fq * 8);
#define PG8_SA(b, h) (((b) * 2 + (h)) * HTB)
#define PG8_SB(b, h) ((4 + (b) * 2 + (h)) * HTB)
#define PG8_STAGE(bufoff, gbase, voff) do { _Pragma("unroll") for (int _i = 0; _i < 2; ++_i) \
        __builtin_amdgcn_global_load_lds((const unsigned*)((const char*)(gbase) + (voff)[_i]), (LAS unsigned*)(lds + (bufoff) + ldsw + _i * 8192), 16, 0, 0); } while (0)
#define PG8_LDA(dst, b, h) do { _Pragma("unroll") for (int m = 0; m < 4; ++m) _Pragma("unroll") for (int k = 0; k < 2; ++k) dst[m][k] = *(const LAS bf16x8*)(lds + PG8_SA(b, h) + aoff + m * 2048 + k * 1024); } while (0)
#define PG8_LDB(dst, b, h) do { _Pragma("unroll") for (int n = 0; n < 2; ++n) _Pragma("unroll") for (int k = 0; k < 2; ++k) dst[n][k] = *(const LAS bf16x8*)(lds + PG8_SB(b, h) + boff + n * 2048 + k * 1024); } while (0)
#define PG8_MMA(ai, bj, At, Bt) do { __builtin_amdgcn_s_setprio(1); _Pragma("unroll") for (int m = 0; m < 4; ++m) _Pragma("unroll") for (int n = 0; n < 2; ++n) _Pragma("unroll") for (int k = 0; k < 2; ++k) \
        acc[ai][bj][m][n] = __builtin_amdgcn_mfma_f32_16x16x32_bf16(Bt[n][k], At[m][k], acc[ai][bj][m][n], 0, 0, 0); __builtin_amdgcn_s_setprio(0); } while (0)
#define PG8_WAIT_V(n) asm volatile("s_waitcnt vmcnt(" #n ")" ::: "memory")
#define PG8_WAIT_L(n) asm volatile("s_waitcnt lgkmcnt(" #n ")" ::: "memory")
#define PG8_BAR __builtin_amdgcn_s_barrier()
#define PG8_SCHED __builtin_amdgcn_sched_barrier(0)
    Unit cur, nxt; int ui = 0;
    if (!S.next(0, cur)) return;
    f32x4 acc[2][2][4][2];
#pragma unroll
    for (int a = 0; a < 2; ++a)
#pragma unroll
        for (int b = 0; b < 2; ++b)
#pragma unroll
            for (int m = 0; m < 4; ++m)
#pragma unroll
                for (int n = 0; n < 2; ++n) acc[a][b][m][n] = (f32x4){0.f, 0.f, 0.f, 0.f};
    bf16x8 At[4][2], B0[2][2], B1[2][2];
    const char* cA = (const char*)g.A + (size_t)cur.pm * tstepA + (size_t)cur.k0 * kstep; const char* cB = (const char*)g.Bt + (size_t)cur.pn * tstepB + (size_t)cur.k0 * kstep;
    S.a_ready(cur);
    PG8_STAGE(PG8_SB(0, 0), cB, voffB); PG8_STAGE(PG8_SB(0, 1), cB + hstepB, voffB); PG8_STAGE(PG8_SA(0, 0), cA, voffA); PG8_STAGE(PG8_SA(0, 1), cA + hstepA, voffA);
    if (wr == 1) PG8_BAR;
    PG8_WAIT_V(2); PG8_BAR;
    PG8_STAGE(PG8_SB(1, 0), cB + kstep, voffB); PG8_STAGE(PG8_SA(1, 0), cA + kstep, voffA); PG8_STAGE(PG8_SB(1, 1), cB + hstepB + kstep, voffB);
    PG8_WAIT_V(6); PG8_BAR;
    for (;;) {
        const bool has_next = S.next(ui + 1, nxt);
        const char* nA = has_next ? (const char*)g.A + (size_t)nxt.pm * tstepA + (size_t)nxt.k0 * kstep : cA; const char* nB = has_next ? (const char*)g.Bt + (size_t)nxt.pn * tstepB + (size_t)nxt.k0 * kstep : cB;
        const int nt = cur.nt;
        for (int t = 0; t < nt; t += 2) {
            const bool last = (t == nt - 2);
            const char* a1 = cA + (size_t)(t + 1) * kstep;
            const char* a2 = last ? nA : cA + (size_t)(t + 2) * kstep; const char* b2 = last ? nB : cB + (size_t)(t + 2) * kstep;
            const char* a3 = a2 + kstep; const char* b3 = b2 + kstep;
            if (last && has_next) S.a_ready(nxt);
            PG8_LDB(B0, 0, 0); PG8_LDB(B1, 0, 1); PG8_SCHED; PG8_LDA(At, 0, 0); PG8_STAGE(PG8_SA(1, 1), a1 + hstepA, voffA);
            PG8_WAIT_V(8); PG8_WAIT_L(0); PG8_BAR; PG8_MMA(0, 0, At, B0); PG8_MMA(0, 1, At, B1); PG8_BAR; PG8_SCHED;
            PG8_LDA(At, 0, 1); PG8_STAGE(PG8_SB(0, 0), b2, voffB); PG8_STAGE(PG8_SB(0, 1), b2 + hstepB, voffB); PG8_STAGE(PG8_SA(0, 0), a2, voffA);
            PG8_WAIT_V(8); PG8_WAIT_L(0); PG8_BAR; PG8_MMA(1, 0, At, B0); PG8_MMA(1, 1, At, B1); PG8_BAR; PG8_SCHED;
            PG8_LDB(B0, 1, 0); PG8_LDB(B1, 1, 1); PG8_SCHED; PG8_LDA(At, 1, 0); PG8_STAGE(PG8_SA(0, 1), a2 + hstepA, voffA);
            PG8_WAIT_V(8); PG8_WAIT_L(0); PG8_BAR; PG8_MMA(0, 0, At, B0); PG8_MMA(0, 1, At, B1); PG8_BAR; PG8_SCHED;
            PG8_LDA(At, 1, 1); PG8_STAGE(PG8_SB(1, 0), b3, voffB); PG8_STAGE(PG8_SB(1, 1), b3 + hstepB, voffB); PG8_STAGE(PG8_SA(1, 0), a3, voffA);
            PG8_WAIT_V(8); PG8_WAIT_L(0); PG8_BAR; PG8_MMA(1, 0, At, B0); PG8_MMA(1, 1, At, B1); PG8_BAR; PG8_SCHED;
        }
        if (wr == 0) PG8_BAR;
        E(acc, cur, wr, wc, fr, fq); S.done(cur);
        if (!has_next) break;
#pragma unroll
        for (int a = 0; a < 2; ++a)
#pragma unroll
            for (int b = 0; b < 2; ++b)
#pragma unroll
                for (int m = 0; m < 4; ++m)
#pragma unroll
                    for (int n = 0; n < 2; ++n) acc[a][b][m][n] = (f32x4){0.f, 0.f, 0.f, 0.f};
        cur = nxt; cA = nA; cB = nB; ++ui;
        if (wr == 1) PG8_BAR;
    }
    PG8_WAIT_V(0);
    PG8_BAR;
#undef PG8_SA
#undef PG8_SB
#undef PG8_STAGE
#undef PG8_LDA
#undef PG8_LDB
#undef PG8_MMA
#undef PG8_WAIT_V
#undef PG8_WAIT_L
#undef PG8_BAR
#undef PG8_SCHED
}

enum { EK_CONVIN = 0, EK_RESID = 1, EK_BF16 = 2, EK_SWIGLU = 3, EK_F32 = 4, EK_MLAQ = 5, EK_MLAD = 6, EK_QKV = 7 };
typedef f32x4 AccT[2][2][4][2];

template <int KIND> struct Epi {
    static constexpr bool PERM = (KIND != EK_RESID && KIND != EK_F32);
    bf16_t* O; int ldc;
    float* Cf;
    const bf16_t* srcL; const bf16_t* srcC; bf16_t* dstL; bf16_t* dstC; const float* gate;
    const float* cosT; const float* sinT;
    float inv_n;
    LAS unsigned char* xlds;
    float* slab;
    bf16_t* O2; bf16_t* O3; const float* g1; const float* g2; u64* ssa; u64* ssb;
    const u64* ss; const float* shw; int shwN;
    const float* gnext; const float* scnext; u64* ssnext; bf16_t* XS;

    DI void coefs(int mi, int row0, int colbase, int nstep, float (&rs)[2][4], f32x4 (&sw)[2][2]) const {
        const float in_ = inv_n > 0.f ? inv_n : (1.f / DM);
#pragma unroll
        for (int ai = 0; ai < 2; ++ai)
#pragma unroll
            for (int m = 0; m < 4; ++m) rs[ai][m] = ss ? 1.0f / sqrtf(SSQ_UNFIX(ss[row0 + ai * HALF + m * 16]) * in_ + EPS) : 1.f;
#pragma unroll
        for (int bj = 0; bj < 2; ++bj)
#pragma unroll
            for (int n = 0; n < 2; ++n) sw[bj][n] = shw ? *(const f32x4*)(shw + (size_t)mi * shwN + colbase + bj * HALF + n * nstep) : (f32x4){0.f, 0.f, 0.f, 0.f};
    }

    DI void operator()(const AccT& acc, const Unit& u, int wr, int wc, int fr, int fq) const {
        const int row0 = u.pm * BM + wr * 64 + fr;
        const int mi_ = (u.pm % 9 == 0) ? 8 : u.pm / 9;
        if constexpr (KIND == EK_RESID) {
            const int b = u.pm / 9, tq = u.pm - b * 9, mi = tq == 0 ? 8 : b;
            const size_t rowbase = tq == 0 ? (size_t)b * CTXL : (size_t)b * SEQ + (size_t)(tq - 1) * 256;
            const bf16_t* src = tq == 0 ? srcC : srcL; bf16_t* dst = tq == 0 ? dstC : dstL;
            const int col0 = u.pn * BM + wc * 32 + 4 * fq;
            if (u.part) {
                float* sp = slab + (size_t)((b * 4 + u.pn) * 4 + (u.part - 1)) * 65536 + (size_t)(wr * 64 + fr) * 256 + wc * 32 + 4 * fq;
#pragma unroll
                for (int ai = 0; ai < 2; ++ai)
#pragma unroll
                    for (int m = 0; m < 4; ++m)
#pragma unroll
                        for (int bj = 0; bj < 2; ++bj)
#pragma unroll
                            for (int n = 0; n < 2; ++n) *(f32x4*)(sp + (ai * HALF + m * 16) * 256 + bj * HALF + n * 16) = acc[ai][bj][m][n];
                return;
            }
            f32x4 gv[2][2], gsv[2][2]; const bool fuse = gnext != nullptr;
#pragma unroll
            for (int bj = 0; bj < 2; ++bj)
#pragma unroll
                for (int n = 0; n < 2; ++n) { gv[bj][n] = *(const f32x4*)(gate + (size_t)mi * NMOD + col0 + bj * HALF + n * 16);
                    if (fuse) { const f32x4 g4 = *(const f32x4*)(gnext + col0 + bj * HALF + n * 16), s4 = *(const f32x4*)(scnext + (size_t)mi * NMOD + col0 + bj * HALF + n * 16); gsv[bj][n] = g4 * (s4 + 1.0f); }
                    else gsv[bj][n] = (f32x4){0.f, 0.f, 0.f, 0.f}; }
            float sq[2][4];
#pragma unroll
            for (int ai = 0; ai < 2; ++ai) {
                    u32x2 xv[4][2][2];
#pragma unroll
                    for (int mm = 0; mm < 4; ++mm)
#pragma unroll
                        for (int bj = 0; bj < 2; ++bj)
#pragma unroll
                            for (int n = 0; n < 2; ++n) xv[mm][bj][n] = *(const u32x2*)(src + (rowbase + wr * 64 + fr + ai * HALF + mm * 16) * DM + col0 + bj * HALF + n * 16);
#pragma unroll
                    for (int m = 0; m < 4; ++m) { const size_t off = (rowbase + wr * 64 + fr + ai * HALF + m * 16) * DM + col0; float sacc = 0.f;
                        bf16_t* xsp = XS + (size_t)(row0 + ai * HALF + m * 16) * DM + col0;
#pragma unroll
                        for (int bj = 0; bj < 2; ++bj)
#pragma unroll
                            for (int n = 0; n < 2; ++n) { const size_t o = off + bj * HALF + n * 16; const u32x2 t = xv[m][bj][n];
                                const f32x4 x0 = {bflo(t.x), bfhi(t.x), bflo(t.y), bfhi(t.y)};
                                const f32x4 xn = x0 + gv[bj][n] * acc[ai][bj][m][n];
                                u32x2 wx; wx.x = cvt_pk_bf16(xn.x, xn.y); wx.y = cvt_pk_bf16(xn.z, xn.w); *(u32x2*)(dst + o) = wx;
                                if (fuse) { sacc += (xn.x * xn.x + xn.y * xn.y) + (xn.z * xn.z + xn.w * xn.w); const f32x4 xs = xn * gsv[bj][n];
                                    u32x2 w2; w2.x = cvt_pk_bf16(xs.x, xs.y); w2.y = cvt_pk_bf16(xs.z, xs.w); *(u32x2*)(xsp + bj * HALF + n * 16) = w2; } }
                        sq[ai][m] = sacc; }
                }
            if (fuse) {
#pragma unroll
                for (int ai = 0; ai < 2; ++ai)
#pragma unroll
                    for (int m = 0; m < 4; ++m) { float t = sq[ai][m]; t += __shfl_xor(t, 16); t += __shfl_xor(t, 32);
                        if (fq == 0) atomicAdd(ssnext + row0 + ai * HALF + m * 16, SSQ_FIX(t)); }
            }
        } else if constexpr (KIND == EK_F32) {
            const int col0 = u.pn * BM + wc * 32 + 4 * fq;
            float rs[2][4]; f32x4 sw[2][2]; coefs(mi_, row0, col0, 16, rs, sw);
#pragma unroll
            for (int ai = 0; ai < 2; ++ai)
#pragma unroll
                for (int m = 0; m < 4; ++m) { float* rowp = Cf + (size_t)(row0 + ai * HALF + m * 16) * ldc + col0;
#pragma unroll
                    for (int bj = 0; bj < 2; ++bj)
#pragma unroll
                        for (int n = 0; n < 2; ++n) *(f32x4*)(rowp + bj * HALF + n * 16) = acc[ai][bj][m][n] * rs[ai][m] + sw[bj][n]; }
        } else if constexpr (KIND == EK_BF16) {
            const int col0 = u.pn * BM + wc * 32 + 8 * fq;
            float rs[2][4]; f32x4 sw[2][2]; coefs(mi_, row0, col0, 4, rs, sw);
#pragma unroll
            for (int ai = 0; ai < 2; ++ai)
#pragma unroll
                for (int m = 0; m < 4; ++m) { bf16_t* rowp = O + (size_t)(row0 + ai * HALF + m * 16) * ldc + col0;
#pragma unroll
                    for (int bj = 0; bj < 2; ++bj) { const f32x4 v0 = acc[ai][bj][m][0] * rs[ai][m] + sw[bj][0], v1 = acc[ai][bj][m][1] * rs[ai][m] + sw[bj][1];
                        u32x4 w; w.x = cvt_pk_bf16(v0[0], v0[1]); w.y = cvt_pk_bf16(v0[2], v0[3]); w.z = cvt_pk_bf16(v1[0], v1[1]); w.w = cvt_pk_bf16(v1[2], v1[3]);
                        *(u32x4*)(rowp + bj * HALF) = w; } }
        } else if constexpr (KIND == EK_CONVIN) {
            float rs[2][4]; f32x4 sw[2][2]; coefs(mi_, row0, u.pn * BM + wc * 32 + 8 * fq, 4, rs, sw);
            if (u.pn < 4) {
                const int col0 = u.pn * BM + wc * 32 + 8 * fq;
#pragma unroll
                for (int ai = 0; ai < 2; ++ai)
#pragma unroll
                    for (int m = 0; m < 4; ++m) { bf16_t* rowp = O + (size_t)(row0 + ai * HALF + m * 16) * 2048 + col0;
#pragma unroll
                        for (int bj = 0; bj < 2; ++bj) { const f32x4 v0 = acc[ai][bj][m][0] * rs[ai][m] + sw[bj][0], v1 = acc[ai][bj][m][1] * rs[ai][m] + sw[bj][1];
                            u32x4 w; w.x = cvt_pk_bf16(v0[0], v0[1]); w.y = cvt_pk_bf16(v0[2], v0[3]); w.z = cvt_pk_bf16(v1[0], v1[1]); w.w = cvt_pk_bf16(v1[2], v1[3]);
                            *(u32x4*)(rowp + bj * HALF) = w; } }
            } else {
                const int col0 = 1024 + (u.pn - 4) * HALF + wc * 32 + 8 * fq;
#pragma unroll
                for (int ai = 0; ai < 2; ++ai)
#pragma unroll
                    for (int m = 0; m < 4; ++m) { bf16_t* rowp = O + (size_t)(row0 + ai * HALF + m * 16) * 2048 + col0;
                        const f32x4 v0 = (acc[ai][0][m][0] * rs[ai][m] + sw[0][0]) * (acc[ai][1][m][0] * rs[ai][m] + sw[1][0]);
                        const f32x4 v1 = (acc[ai][0][m][1] * rs[ai][m] + sw[0][1]) * (acc[ai][1][m][1] * rs[ai][m] + sw[1][1]);
                        u32x4 w; w.x = cvt_pk_bf16(v0[0], v0[1]); w.y = cvt_pk_bf16(v0[2], v0[3]); w.z = cvt_pk_bf16(v1[0], v1[1]); w.w = cvt_pk_bf16(v1[2], v1[3]);
                        *(u32x4*)rowp = w; }
            }
        } else if constexpr (KIND == EK_SWIGLU) {
            const int col0 = u.pn * HALF + wc * 32 + 8 * fq;
            float rs[2][4]; f32x4 sw[2][2]; coefs(mi_, row0, u.pn * BM + wc * 32 + 8 * fq, 4, rs, sw);
#pragma unroll
            for (int ai = 0; ai < 2; ++ai)
#pragma unroll
                for (int m = 0; m < 4; ++m) { bf16_t* rowp = O + (size_t)(row0 + ai * HALF + m * 16) * FF + col0;
                    f32x4 v[2];
#pragma unroll
                    for (int n = 0; n < 2; ++n) { const f32x4 a = acc[ai][0][m][n] * rs[ai][m] + sw[0][n], bb = acc[ai][1][m][n] * rs[ai][m] + sw[1][n];
                        const f32x4 t = a * (-1.4426950408889634f); f32x4 e;
                        e.x = __builtin_amdgcn_exp2f(t.x); e.y = __builtin_amdgcn_exp2f(t.y); e.z = __builtin_amdgcn_exp2f(t.z); e.w = __builtin_amdgcn_exp2f(t.w);
                        const f32x4 d = e + 1.0f; f32x4 r;
                        r.x = __builtin_amdgcn_rcpf(d.x); r.y = __builtin_amdgcn_rcpf(d.y); r.z = __builtin_amdgcn_rcpf(d.z); r.w = __builtin_amdgcn_rcpf(d.w);
                        v[n] = (a * bb) * r; }
                    u32x4 w; w.x = cvt_pk_bf16(v[0][0], v[0][1]); w.y = cvt_pk_bf16(v[0][2], v[0][3]); w.z = cvt_pk_bf16(v[1][0], v[1][1]); w.w = cvt_pk_bf16(v[1][2], v[1][3]);
                    *(u32x4*)rowp = w; }
        } else if constexpr (KIND == EK_QKV) {
            float rs[2][4]; f32x4 sw[2][2]; coefs(mi_, row0, u.pn * BM + wc * 32 + 8 * fq, 4, rs, sw);
            LAS float* xch = (LAS float*)xlds;
            const int wid8 = wr * 4 + wc;
            f32x4 v[2][4][2][2];
#pragma unroll
            for (int ai = 0; ai < 2; ++ai)
#pragma unroll
                for (int m = 0; m < 4; ++m) { float sacc = 0.f;
#pragma unroll
                    for (int bj = 0; bj < 2; ++bj)
#pragma unroll
                        for (int n = 0; n < 2; ++n) { const f32x4 t = acc[ai][bj][m][n] * rs[ai][m] + sw[bj][n]; v[ai][m][bj][n] = t; sacc += (t.x * t.x + t.y * t.y) + (t.z * t.z + t.w * t.w); }
                    sacc += __shfl_xor(sacc, 16); sacc += __shfl_xor(sacc, 32);
                    if (fq == 0) xch[wid8 * 128 + (ai * 4 + m) * 16 + fr] = sacc; }
            asm volatile("s_waitcnt lgkmcnt(0)" ::: "memory"); __builtin_amdgcn_s_barrier(); asm volatile("" ::: "memory");
            if (u.pn < 5) {
                const int hd = 2 * u.pn + (wc >> 1), dd = 32 * (wc & 1) + 8 * fq;
                const float* gg = (u.pn < 4 ? g1 : g2);
                f32x4 ga[2][2];
#pragma unroll
                for (int bj = 0; bj < 2; ++bj)
#pragma unroll
                    for (int n = 0; n < 2; ++n) ga[bj][n] = *(const f32x4*)(gg + bj * 64 + dd + 4 * n);
                const int tq = u.pm % 9; const bool lat = tq != 0;
#pragma unroll
                for (int ai = 0; ai < 2; ++ai)
#pragma unroll
                    for (int m = 0; m < 4; ++m) { const int slot = (ai * 4 + m) * 16 + fr, lrow = wr * 64 + fr + ai * HALF + m * 16;
                        const float tot = xch[wid8 * 128 + slot] + xch[(wid8 ^ 1) * 128 + slot];
                        const float rn = 1.0f / sqrtf(tot * (1.f / 128.f) + EPS);
                        bf16_t* rowp = O + (size_t)(u.pm * BM + lrow) * 1536 + hd * 128 + dd;
                        f32x4 o1[2], o2[2];
#pragma unroll
                        for (int n = 0; n < 2; ++n) { const f32x4 y1 = v[ai][m][0][n] * rn * ga[0][n], y2 = v[ai][m][1][n] * rn * ga[1][n];
                            if (lat) { const int pos = (tq - 1) * 256 + lrow; const f32x4 cv = *(const f32x4*)(cosT + pos * 64 + dd + 4 * n), sv = *(const f32x4*)(sinT + pos * 64 + dd + 4 * n);
                                o1[n] = y1 * cv - y2 * sv; o2[n] = y1 * sv + y2 * cv; }
                            else { o1[n] = y1; o2[n] = y2; } }
                        u32x4 w; w.x = cvt_pk_bf16(o1[0][0], o1[0][1]); w.y = cvt_pk_bf16(o1[0][2], o1[0][3]); w.z = cvt_pk_bf16(o1[1][0], o1[1][1]); w.w = cvt_pk_bf16(o1[1][2], o1[1][3]);
                        *(u32x4*)rowp = w;
                        w.x = cvt_pk_bf16(o2[0][0], o2[0][1]); w.y = cvt_pk_bf16(o2[0][2], o2[0][3]); w.z = cvt_pk_bf16(o2[1][0], o2[1][1]); w.w = cvt_pk_bf16(o2[1][2], o2[1][3]);
                        *(u32x4*)(rowp + 64) = w; }
            } else {
                const int col0 = u.pn * BM + wc * 32 + 8 * fq;
#pragma unroll
                for (int ai = 0; ai < 2; ++ai)
#pragma unroll
                    for (int m = 0; m < 4; ++m) { bf16_t* rowp = O + (size_t)(row0 + ai * HALF + m * 16) * 1536 + col0;
#pragma unroll
                        for (int bj = 0; bj < 2; ++bj) { const f32x4 v0 = v[ai][m][bj][0], v1 = v[ai][m][bj][1];
                            u32x4 w; w.x = cvt_pk_bf16(v0[0], v0[1]); w.y = cvt_pk_bf16(v0[2], v0[3]); w.z = cvt_pk_bf16(v1[0], v1[1]); w.w = cvt_pk_bf16(v1[2], v1[3]);
                            *(u32x4*)(rowp + bj * HALF) = w; } }
            }
            asm volatile("s_waitcnt lgkmcnt(0)" ::: "memory"); __builtin_amdgcn_s_barrier(); asm volatile("" ::: "memory");
        } else if constexpr (KIND == EK_MLAD) {
            float rs[2][4]; f32x4 sw[2][2]; coefs(mi_, row0, u.pn * BM + wc * 32 + 8 * fq, 4, rs, sw);
            if (u.pn < 4) {
                const bool isq = u.pn < 3;
                bf16_t* base = isq ? O : O2; const int ld = isq ? 768 : 256; const int cbase = (isq ? u.pn * BM : 0) + wc * 32 + 8 * fq;
                const float* gg = (isq ? g1 : g2) + cbase; u64* ssp = isq ? ssa : ssb;
                f32x4 gvv[2][2];
#pragma unroll
                for (int bj = 0; bj < 2; ++bj)
#pragma unroll
                    for (int n = 0; n < 2; ++n) gvv[bj][n] = *(const f32x4*)(gg + bj * HALF + 4 * n);
#pragma unroll
                for (int ai = 0; ai < 2; ++ai)
#pragma unroll
                    for (int m = 0; m < 4; ++m) { const int row = row0 + ai * HALF + m * 16; float sacc = 0.f;
#pragma unroll
                        for (int bj = 0; bj < 2; ++bj) { const f32x4 v0 = acc[ai][bj][m][0] * rs[ai][m] + sw[bj][0], v1 = acc[ai][bj][m][1] * rs[ai][m] + sw[bj][1];
                            sacc += ((v0.x * v0.x + v0.y * v0.y) + (v0.z * v0.z + v0.w * v0.w)) + ((v1.x * v1.x + v1.y * v1.y) + (v1.z * v1.z + v1.w * v1.w));
                            const f32x4 o0 = v0 * gvv[bj][0], o1 = v1 * gvv[bj][1];
                            u32x4 w; w.x = cvt_pk_bf16(o0[0], o0[1]); w.y = cvt_pk_bf16(o0[2], o0[3]); w.z = cvt_pk_bf16(o1[0], o1[1]); w.w = cvt_pk_bf16(o1[2], o1[3]);
                            *(u32x4*)(base + (size_t)row * ld + cbase + bj * HALF) = w; }
                        sacc += __shfl_xor(sacc, 16); sacc += __shfl_xor(sacc, 32);
                        if (fq == 0) atomicAdd(ssp + row, SSQ_FIX(sacc)); }
            } else if (wc == 0) {
                const int tq = u.pm % 9; const bool lat = tq != 0;
#pragma unroll
                for (int ai = 0; ai < 2; ++ai)
#pragma unroll
                    for (int m = 0; m < 4; ++m) { const int lrow = wr * 64 + fr + ai * HALF + m * 16;
                        bf16_t* rowp = O3 + (size_t)(u.pm * BM + lrow) * 64 + 8 * fq;
                        f32x4 o1[2], o2[2];
#pragma unroll
                        for (int n = 0; n < 2; ++n) { const f32x4 x1 = acc[ai][0][m][n] * rs[ai][m] + sw[0][n], x2 = acc[ai][1][m][n] * rs[ai][m] + sw[1][n];
                            if (lat) { const int pos = (tq - 1) * 256 + lrow; const f32x4 cv = *(const f32x4*)(cosT + pos * 32 + 8 * fq + 4 * n), sv = *(const f32x4*)(sinT + pos * 32 + 8 * fq + 4 * n);
                                o1[n] = x1 * cv - x2 * sv; o2[n] = x1 * sv + x2 * cv; }
                            else { o1[n] = x1; o2[n] = x2; } }
                        u32x4 w; w.x = cvt_pk_bf16(o1[0][0], o1[0][1]); w.y = cvt_pk_bf16(o1[0][2], o1[0][3]); w.z = cvt_pk_bf16(o1[1][0], o1[1][1]); w.w = cvt_pk_bf16(o1[1][2], o1[1][3]);
                        *(u32x4*)rowp = w;
                        w.x = cvt_pk_bf16(o2[0][0], o2[0][1]); w.y = cvt_pk_bf16(o2[0][2], o2[0][3]); w.z = cvt_pk_bf16(o2[1][0], o2[1][1]); w.w = cvt_pk_bf16(o2[1][2], o2[1][3]);
                        *(u32x4*)(rowp + 32) = w; }
            }
        } else {
            float rs[2][4]; f32x4 sw[2][2]; coefs(mi_, row0, 0, 4, rs, sw);
            if (u.pn < 4) {
#pragma unroll
                for (int ai = 0; ai < 2; ++ai)
#pragma unroll
                    for (int m = 0; m < 4; ++m) { bf16_t* rowp = O + (size_t)(row0 + ai * HALF + m * 16) * 1536 + wc * 32 + 8 * fq;
#pragma unroll
                        for (int bj = 0; bj < 2; ++bj) { const f32x4 v0 = acc[ai][bj][m][0] * rs[ai][m], v1 = acc[ai][bj][m][1] * rs[ai][m];
                            u32x4 w; w.x = cvt_pk_bf16(v0[0], v0[1]); w.y = cvt_pk_bf16(v0[2], v0[3]); w.z = cvt_pk_bf16(v1[0], v1[1]); w.w = cvt_pk_bf16(v1[2], v1[3]);
                            *(u32x4*)(rowp + (2 * u.pn + bj) * 192) = w; } }
            } else {
                const int head = 4 * (u.pn - 4) + wc, j0 = 8 * fq;
                const int tq = u.pm % 9; const bool lat = tq != 0;
#pragma unroll
                for (int ai = 0; ai < 2; ++ai)
#pragma unroll
                    for (int m = 0; m < 4; ++m) { const int lrow = wr * 64 + fr + ai * HALF + m * 16;
                        bf16_t* rowp = O + (size_t)(u.pm * BM + lrow) * 1536 + head * 192 + 128 + j0;
                        f32x4 o1[2], o2[2];
                        if (lat) { const int pos = (tq - 1) * 256 + lrow;
#pragma unroll
                            for (int n = 0; n < 2; ++n) { const f32x4 cv = *(const f32x4*)(cosT + pos * 32 + j0 + 4 * n), sv = *(const f32x4*)(sinT + pos * 32 + j0 + 4 * n);
                                const f32x4 x1 = acc[ai][0][m][n] * rs[ai][m], x2 = acc[ai][1][m][n] * rs[ai][m]; o1[n] = x1 * cv - x2 * sv; o2[n] = x1 * sv + x2 * cv; }
                        } else { o1[0] = acc[ai][0][m][0] * rs[ai][m]; o1[1] = acc[ai][0][m][1] * rs[ai][m]; o2[0] = acc[ai][1][m][0] * rs[ai][m]; o2[1] = acc[ai][1][m][1] * rs[ai][m]; }
                        u32x4 w; w.x = cvt_pk_bf16(o1[0][0], o1[0][1]); w.y = cvt_pk_bf16(o1[0][2], o1[0][3]); w.z = cvt_pk_bf16(o1[1][0], o1[1][1]); w.w = cvt_pk_bf16(o1[1][2], o1[1][3]);
                        *(u32x4*)rowp = w;
                        w.x = cvt_pk_bf16(o2[0][0], o2[0][1]); w.y = cvt_pk_bf16(o2[0][2], o2[0][3]); w.z = cvt_pk_bf16(o2[1][0], o2[1][1]); w.w = cvt_pk_bf16(o2[1][2], o2[1][3]);
                        *(u32x4*)(rowp + 32) = w; }
            }
        }
    }
};
}

namespace att {
constexpr int NW = 8, QBLK = 32, KVBLK = 64;
constexpr float THR = 8.f;
constexpr int SHM_V = KVBLK * 128 * 2;
#define SBAR() __builtin_amdgcn_sched_barrier(0)
DI int crow(int r, int hi) { return (r & 3) + 8 * (r >> 2) + 4 * hi; }
DI unsigned cvtpk(float lo, float hi) { unsigned r; asm volatile("v_cvt_pk_bf16_f32 %0, %1, %2" : "=v"(r) : "v"(lo), "v"(hi)); return r; }
DI bf16x8 ld8(const bf16_t* p) { return *reinterpret_cast<const bf16x8*>(p); }

template <int DQK> struct Sc { static constexpr float SCALE = DQK == 128 ? 0.088388347648318440f : 0.072168783648703220f; };

template <int DQK>
DI void partialSM(f32x16& p0, f32x16& p1, float& m_reg, float& mn, float& alpha) {
  constexpr float SCALE = Sc<DQK>::SCALE;
  constexpr float C = SCALE * 1.4426950408889634f;
  float pmax = p0[0];
#pragma unroll
  for (int r = 1; r < 16; ++r) pmax = fmaxf(pmax, p0[r]);
#pragma unroll
  for (int r = 0; r < 16; ++r) pmax = fmaxf(pmax, p1[r]);
  { auto rr = __builtin_amdgcn_permlane32_swap(__float_as_uint(pmax), __float_as_uint(pmax), false, false);
    pmax = fmaxf(__uint_as_float(rr[0]), __uint_as_float(rr[1])); }
  if (__builtin_expect(__all(pmax - m_reg <= THR / SCALE), 1)) { mn = m_reg; alpha = 1.f; }
  else { mn = fmaxf(m_reg, pmax); alpha = __builtin_amdgcn_exp2f((m_reg - mn) * C); m_reg = mn; }
  float mnC = -mn * C;
#pragma unroll
  for (int r = 0; r < 16; ++r) p0[r] = fmaf(p0[r], C, mnC);
#pragma unroll
  for (int r = 0; r < 16; ++r) p1[r] = fmaf(p1[r], C, mnC);
#pragma unroll
  for (int r = 0; r < 16; ++r) p0[r] = __builtin_amdgcn_exp2f(p0[r]);
}
DI void finishSM(f32x16& p0, f32x16& p1, float alpha, float& l_reg, bf16x8& pa0, bf16x8& pa1, bf16x8& pa2, bf16x8& pa3) {
#pragma unroll
  for (int r = 0; r < 16; ++r) p1[r] = __builtin_amdgcn_exp2f(p1[r]);
  float ps = 0;
#pragma unroll
  for (int r = 0; r < 16; ++r) ps += p0[r];
#pragma unroll
  for (int r = 0; r < 16; ++r) ps += p1[r];
  { auto rr = __builtin_amdgcn_permlane32_swap(__float_as_uint(ps), __float_as_uint(ps), false, false);
    ps = __uint_as_float(rr[0]) + __uint_as_float(rr[1]); }
  l_reg = l_reg * alpha + ps;
#define PK4(P, BASE, OUT) do { unsigned a0 = cvtpk(P[BASE + 0], P[BASE + 1]), a1 = cvtpk(P[BASE + 2], P[BASE + 3]);   \
    unsigned b0 = cvtpk(P[BASE + 4], P[BASE + 5]), b1 = cvtpk(P[BASE + 6], P[BASE + 7]);                              \
    auto r0 = __builtin_amdgcn_permlane32_swap(a0, b0, false, false); auto r1 = __builtin_amdgcn_permlane32_swap(a1, b1, false, false); \
    u32x4 w = {r0[0], r1[0], r0[1], r1[1]}; OUT = *reinterpret_cast<bf16x8*>(&w); } while (0)
  PK4(p0, 0, pa0); PK4(p0, 8, pa1); PK4(p1, 0, pa2); PK4(p1, 8, pa3);
#undef PK4
}
#define KSWZ2(row, colB, RB) ((row) * (RB) + ((colB) ^ (((row) & 7) << 4)))
template <int DQK>
DI void qkt(f32x16& p0, f32x16& p1, const char* Ks, const bf16x8* qr, const char* qx, int r32, int hi) {
  constexpr int RB = DQK * 2;
  p0 = f32x16{}; p1 = f32x16{};
#pragma unroll
  for (int d0 = 0; d0 < DQK / 16; ++d0) { int cb = (d0 * 16 + hi * 8) * 2;
    bf16x8 b0 = *reinterpret_cast<const bf16x8*>(Ks + KSWZ2(r32, cb, RB));
    bf16x8 b1 = *reinterpret_cast<const bf16x8*>(Ks + KSWZ2(32 + r32, cb, RB));
    bf16x8 qf; if (d0 < 8) qf = qr[d0 < 8 ? d0 : 0]; else qf = *reinterpret_cast<const bf16x8*>(qx + (d0 - 8) * 1024);
    p0 = __builtin_amdgcn_mfma_f32_32x32x16_bf16(b0, qf, p0, 0, 0, 0);
    p1 = __builtin_amdgcn_mfma_f32_32x32x16_bf16(b1, qf, p1, 0, 0, 0); }
}
DI int v_st(int k, int c) { const int kk = (k & ~0xC) | ((k & 4) << 1) | ((k & 8) >> 1); return ((kk >> 3) * 4 + (c >> 5)) * 512 + ((kk & 7) * 32 + (c & 31)) * 2; }
DI int v_rd_base(int lane) { return ((lane & 3) << 3) | (((lane >> 2) & 3) << 6) | (((lane >> 4) & 1) << 5) | (((lane >> 5) & 1) << 8); }
constexpr int v_rd_off(int d0, int ks, int half) { return d0 * 512 + ks * 4096 + half * 2048; }
template <int OFF> DI s16x4 tr_read(int vb) {
  s16x4 r; asm volatile("ds_read_b64_tr_b16 %0, %1 offset:%2" : "=&v"(r) : "v"(vb), "i"(OFF) : "memory"); return r;
}
template <int D0> DI void pv_one(f32x16& od, int vb, bf16x8 pa0, bf16x8 pa1, bf16x8 pa2, bf16x8 pa3) {
  const s16x4 l0 = tr_read<v_rd_off(D0, 0, 0)>(vb), h0 = tr_read<v_rd_off(D0, 0, 1)>(vb), l1 = tr_read<v_rd_off(D0, 1, 0)>(vb), h1 = tr_read<v_rd_off(D0, 1, 1)>(vb);
  const s16x4 l2 = tr_read<v_rd_off(D0, 2, 0)>(vb), h2 = tr_read<v_rd_off(D0, 2, 1)>(vb), l3 = tr_read<v_rd_off(D0, 3, 0)>(vb), h3 = tr_read<v_rd_off(D0, 3, 1)>(vb);
  asm volatile("s_waitcnt lgkmcnt(0)" ::: "memory"); SBAR();
#define PK(L, H) (bf16x8){L[0], L[1], L[2], L[3], H[0], H[1], H[2], H[3]}
  od = __builtin_amdgcn_mfma_f32_32x32x16_bf16(pa0, PK(l0, h0), od, 0, 0, 0);
  od = __builtin_amdgcn_mfma_f32_32x32x16_bf16(pa1, PK(l1, h1), od, 0, 0, 0);
  od = __builtin_amdgcn_mfma_f32_32x32x16_bf16(pa2, PK(l2, h2), od, 0, 0, 0);
  od = __builtin_amdgcn_mfma_f32_32x32x16_bf16(pa3, PK(l3, h3), od, 0, 0, 0);
#undef PK
}
DI void pv_d0(f32x16* o, int vb, bf16x8 pa0, bf16x8 pa1, bf16x8 pa2, bf16x8 pa3) {
  pv_one<0>(o[0], vb, pa0, pa1, pa2, pa3); pv_one<1>(o[1], vb, pa0, pa1, pa2, pa3); pv_one<2>(o[2], vb, pa0, pa1, pa2, pa3); pv_one<3>(o[3], vb, pa0, pa1, pa2, pa3);
}

template <int DQK, int LDQ, int LDK, int SDEPTH>
DI void attn_body(const bf16_t* Qb, const bf16_t* Kh, const bf16_t* Vh, const bf16_t* Ph, bf16_t* Ob, int seq, char* lds) {
  constexpr int ND = DQK / 16, KRB = DQK * 2, SHM_K = KVBLK * KRB, LDO = 1024;
  const int tid = otid(), wid = tid >> 6, lane = tid & 63, r32 = lane & 31, hi = lane >> 5;
  char* V_lds = lds; char* K_lds = lds + 2 * SHM_V;
  float* ws = (float*)(lds + 2 * SHM_V + 2 * SHM_K) + wid * 64; float* li_l = ws; float* al_l = ws + 32;
  float m_reg = -1e30f, l_reg = 0; f32x16 o[4] = {}; bf16x8 qr[8];
  const bf16_t* Qw = Qb + (long)(wid * QBLK + r32) * LDQ + hi * 8;
#pragma unroll
  for (int d0 = 0; d0 < 8; ++d0) qr[d0] = ld8(Qw + d0 * 16);
  char* qx = lds + 2 * SHM_V + 2 * SHM_K + NW * 256 + wid * 4096 + lane * 16;
  if constexpr (DQK == 192) {
#pragma unroll
    for (int d0 = 8; d0 < ND; ++d0) *reinterpret_cast<bf16x8*>(qx + (d0 - 8) * 1024) = ld8(Qw + d0 * 16);
    asm volatile("s_waitcnt lgkmcnt(0)" ::: "memory");
  }
  const int sr = tid >> 4, sc = (tid & 15) * 8, vst0 = v_st(sr, sc), vst1 = v_st(32 + sr, sc);
  const int pr = tid >> 3, pc = (tid & 7) * 8;
  const int vb0 = (int)(uintptr_t)V_lds + v_rd_base(lane);
  struct { bf16x8 vs0, vs1, ks0, ks1, ps; } sr_[SDEPTH];
#define SLOAD(i, k0) do { sr_[i].vs0 = ld8(&Vh[(long)((k0) + sr) * LDK + sc]); sr_[i].vs1 = ld8(&Vh[(long)((k0) + 32 + sr) * LDK + sc]); \
    sr_[i].ks0 = ld8(&Kh[(long)((k0) + sr) * LDK + sc]); sr_[i].ks1 = ld8(&Kh[(long)((k0) + 32 + sr) * LDK + sc]);                       \
    if constexpr (DQK == 192) sr_[i].ps = ld8(&Ph[(long)((k0) + pr) * 64 + pc]); } while (0)
#define SWRITE(b, i) do { *(bf16x8*)(V_lds + (b) * SHM_V + vst0) = sr_[i].vs0;          \
    *(bf16x8*)(V_lds + (b) * SHM_V + vst1) = sr_[i].vs1; int kc = sc * 2;               \
    *(bf16x8*)(K_lds + (b) * SHM_K + KSWZ2(sr, kc, KRB)) = sr_[i].ks0;                  \
    *(bf16x8*)(K_lds + (b) * SHM_K + KSWZ2(32 + sr, kc, KRB)) = sr_[i].ks1;             \
    if constexpr (DQK == 192) *(bf16x8*)(K_lds + (b) * SHM_K + KSWZ2(pr, 256 + pc * 2, KRB)) = sr_[i].ps; } while (0)
#define SWAIT() do { if constexpr (SDEPTH == 2) { if constexpr (DQK == 192) asm volatile("s_waitcnt vmcnt(5)" ::: "memory"); else asm volatile("s_waitcnt vmcnt(4)" ::: "memory"); } \
    else asm volatile("s_waitcnt vmcnt(0)" ::: "memory"); } while (0)
#define RESC(a) do { if (__any((a) < 1.f)) { if (hi == 0) al_l[r32] = (a); asm volatile("s_waitcnt lgkmcnt(0)" ::: "memory"); \
    _Pragma("unroll") for (int d = 0; d < 4; ++d) _Pragma("unroll") for (int r = 0; r < 16; ++r) o[d][r] *= al_l[crow(r, hi)]; } } while (0)
  f32x16 pA0, pA1, pB0, pB1; float mnA, mnB, alA, alB; bf16x8 pa0, pa1, pa2, pa3; const int NT = seq / KVBLK;
  constexpr int SE = 0, SO = SDEPTH - 1;
  SLOAD(SE, 0); asm volatile("s_waitcnt vmcnt(0)" ::: "memory"); SWRITE(0, SE); __syncthreads();
  qkt<DQK>(pA0, pA1, K_lds, qr, qx, r32, hi); partialSM<DQK>(pA0, pA1, m_reg, mnA, alA);
  SLOAD(SO, KVBLK); if constexpr (SDEPTH == 2) { if (2 < NT) SLOAD(SE, 2 * KVBLK); }
  SWAIT(); SWRITE(1, SO); __syncthreads();
  for (int j = 1; j + 1 < NT; j += 2) {
    SBAR(); qkt<DQK>(pB0, pB1, K_lds + SHM_K, qr, qx, r32, hi);
    finishSM(pA0, pA1, alA, l_reg, pa0, pa1, pa2, pa3); SBAR();
    SLOAD(SO, (j + SDEPTH) * KVBLK); SBAR();
    pv_d0(o, vb0, pa0, pa1, pa2, pa3); partialSM<DQK>(pB0, pB1, m_reg, mnB, alB);
    __syncthreads(); SWAIT(); SWRITE(0, SE);
    RESC(alB); __syncthreads();
    SBAR(); qkt<DQK>(pA0, pA1, K_lds, qr, qx, r32, hi);
    finishSM(pB0, pB1, alB, l_reg, pa0, pa1, pa2, pa3); SBAR();
    if (SDEPTH == 1 || j + 3 < NT) SLOAD(SE, (j + 1 + SDEPTH) * KVBLK); SBAR();
    pv_d0(o, vb0 + (int)SHM_V, pa0, pa1, pa2, pa3); partialSM<DQK>(pA0, pA1, m_reg, mnA, alA);
    __syncthreads(); SWAIT(); SWRITE(1, SO);
    RESC(alA); __syncthreads();
  }
  SBAR(); qkt<DQK>(pB0, pB1, K_lds + SHM_K, qr, qx, r32, hi);
  finishSM(pA0, pA1, alA, l_reg, pa0, pa1, pa2, pa3); SBAR();
  pv_d0(o, vb0, pa0, pa1, pa2, pa3); partialSM<DQK>(pB0, pB1, m_reg, mnB, alB);
  __syncthreads(); RESC(alB);
  finishSM(pB0, pB1, alB, l_reg, pa0, pa1, pa2, pa3); SBAR();
  pv_d0(o, vb0 + (int)SHM_V, pa0, pa1, pa2, pa3);
  if (hi == 0) li_l[r32] = l_reg; asm volatile("s_waitcnt lgkmcnt(0)" ::: "memory");
  float rli[16];
#pragma unroll
  for (int r = 0; r < 16; ++r) rli[r] = __builtin_amdgcn_rcpf(li_l[crow(r, hi)]);
  bf16_t* Ow = Ob + (long)(wid * QBLK) * LDO;
#pragma unroll
  for (int r = 0; r < 16; ++r) { int orow = crow(r, hi);
#pragma unroll
    for (int d0 = 0; d0 < 4; ++d0) Ow[(long)orow * LDO + d0 * 32 + r32] = (bf16_t)f2bf(o[d0][r] * rli[r]); }
#undef SLOAD
#undef SWRITE
#undef SWAIT
#undef RESC
}
}

DI int wrow(int mode, int p0, int n) {
    if (mode == 0) return p0 + n;
    if (mode == 1) { if (n < 1024) return n; const int s = (n - 1024) >> 10, ch = (n - 1024) & 1023; return 1024 + ((ch >> 7) << 8) + (s << 7) + (ch & 127); }
    if (mode == 2) return ((n >> 7) << 8) + (p0 << 7) + (n & 127);
    if (mode == 5) { const int hd = n >> 7, d = n & 127; return p0 + ((hd >> 1) << 8) + ((d >> 6) << 7) + ((hd & 1) << 6) + (d & 63); }
    if (mode == 4) { if (n < 256) return 768 + n; const int j = n - 256; return 1024 + ((j >> 5) << 7) + (j & 31); }
    const int h = n / 192, d = n - h * 192;
    if (d < 128) return ((h >> 1) << 8) + ((h & 1) << 7) + d;
    const int j = d - 128; return 1024 + ((h >> 2) << 8) + ((j >> 5) << 7) + ((h & 3) << 5) + (j & 31);
}
DI void transpose_item(const float* W, int K, int N, bf16_t* WT, int mode, int p0, LAS float* scr, int item, int lane) {
    const int nblk = N / 32, kb = item / nblk, nb = item - kb * nblk, k0 = 64 * kb, n0 = 32 * nb;
#pragma unroll
    for (int i = 0; i < 32; ++i) { const int kk = 2 * i + (lane >> 5); scr[kk * 33 + (lane & 31)] = __builtin_nontemporal_load(W + (size_t)(k0 + kk) * N + n0 + (lane & 31)); }
    LDS_WAIT(); asm volatile("" ::: "memory");
    const int c = lane & 7;
#pragma unroll
    for (int j = 0; j < 4; ++j) { const int n = (lane >> 3) + 8 * j; const LAS float* s = scr + (8 * c) * 33 + n;
        u32x4 o; o.x = pk2(s[0 * 33], s[1 * 33]); o.y = pk2(s[2 * 33], s[3 * 33]); o.z = pk2(s[4 * 33], s[5 * 33]); o.w = pk2(s[6 * 33], s[7 * 33]);
        *(u32x4*)(WT + (size_t)wrow(mode, p0, n0 + n) * K + k0 + 8 * c) = o; }
    LDS_WAIT(); asm volatile("" ::: "memory");
}

DI void transposes_items(const Params& P, LAS unsigned char* lds, int first, int last, int slot, int nslots, int deferred, int lane) {
    unsigned char* ws = P.ws; const int wave = otid() >> 6;
    LAS float* scr = (LAS float*)(lds + 61440 + wave * 8448);
    constexpr int I_FF = 1408, I_L = 3 * I_FF, I_CI = 1536, I_CO = 512, I_CV = I_CI + I_CO;
    constexpr int N0 = 4 * I_L, N1 = N0 + 2 * I_CV, N2 = N1 + 512 + 128 + 128 + 512, N3 = N2 + 384 + 160 + 576 + 256 + 512;
    static_assert(N3 - N0 - I_CV + 3 * I_L == 17888 && I_L + I_CV == 6272, "item counts");
    for (int d = first + slot; d < last; d += nslots) {
        int it;
        if (!deferred) it = d < I_L ? d : N0 + (d - I_L);
        else it = d < 3 * I_L ? I_L + d : N0 + I_CV + (d - 3 * I_L);
        const float* W; int K, N, mode = 0, p0 = 0, item; bf16_t* WT;
        if (it < N0) { const int l = it / I_L, q = it - l * I_L, wh = q / I_FF; item = q - wh * I_FF;
            if (wh == 0) { W = P.in[8] + (size_t)l * DM * FF; K = DM; N = FF; WT = (bf16_t*)(ws + WS_WUP + l * SZ_WUP); mode = 2; p0 = 0; }
            else if (wh == 1) { W = P.in[9] + (size_t)l * DM * FF; K = DM; N = FF; WT = (bf16_t*)(ws + WS_WUP + l * SZ_WUP); mode = 2; p0 = 1; }
            else { W = P.in[10] + (size_t)l * FF * DM; K = FF; N = DM; WT = (bf16_t*)(ws + WS_WDN + l * SZ_WDN); } }
        else if (it < N1) { const int r = it - N0, j = r / I_CV, q = r - j * I_CV;
            if (q < I_CI) { item = q; W = P.in[11] + (size_t)j * DM * 3072; K = DM; N = 3072; WT = (bf16_t*)(ws + WS_WCI + j * SZ_WCI); mode = 1; }
            else { item = q - I_CI; W = P.in[13] + (size_t)j * DM * DM; K = DM; N = DM; WT = (bf16_t*)(ws + WS_WCO + j * SZ_WSQ); } }
        else if (it < N2) { int r = it - N1;
            if (r < 512) { item = r; W = P.in[14]; K = DM; N = DM; WT = (bf16_t*)(ws + WS_WQKV); mode = 5; p0 = 0; }
            else if (r < 640) { item = r - 512; W = P.in[15]; K = DM; N = 256; WT = (bf16_t*)(ws + WS_WQKV); mode = 5; p0 = 1024; }
            else if (r < 768) { item = r - 640; W = P.in[16]; K = DM; N = 256; WT = (bf16_t*)(ws + WS_WQKV); p0 = 1280; }
            else { item = r - 768; W = P.in[19]; K = DM; N = DM; WT = (bf16_t*)(ws + WS_WGO); } }
        else { int r = it - N2;
            if (r < 384) { item = r; W = P.in[20]; K = DM; N = 768; WT = (bf16_t*)(ws + WS_WD); p0 = 0; }
            else if (r < 544) { item = r - 384; W = P.in[23]; K = DM; N = 320; WT = (bf16_t*)(ws + WS_WD); mode = 4; }
            else if (r < 1120) { item = r - 544; W = P.in[22]; K = 768; N = 1536; WT = (bf16_t*)(ws + WS_WUQ); mode = 3; }
            else if (r < 1376) { item = r - 1120; W = P.in[25]; K = 256; N = 2048; WT = (bf16_t*)(ws + WS_WUKV); }
            else { item = r - 1376; W = P.in[26]; K = DM; N = DM; WT = (bf16_t*)(ws + WS_WMO); } }
        transpose_item(W, K, N, WT, mode, p0, scr, item, lane);
    }
}

DI void prologue_phase(const Params& P, LAS unsigned char* lds, int G) {
    const int tid = otid(), lane = tid & 63, wave = tid >> 6;
    unsigned char* ws = P.ws;
    {
        LAS float* sc = (LAS float*)lds; LAS float* red = sc + 9 * DM;
        for (int i = tid; i < 9 * DM; i += NTHREADS) { const int r = i >> 10, k = i & 1023; const float v = r < 8 ? P.in[1][r * DM + k] : P.in[3][k]; sc[i] = v / (1.f + __expf(-v)); }
        __syncthreads();
        float* MOD = (float*)(ws + WS_MOD);
        for (int item = blockIdx.x; item < 4 * 48; item += G) {
            const int l = item / 48, n0 = (item - l * 48) * 128, ks = tid >> 5, cq = tid & 31;
            const float* Wp = P.in[4] + ((size_t)l * DM + ks * 64) * NMOD + n0 + 4 * cq;
            f32x4 a[9];
#pragma unroll
            for (int r = 0; r < 9; ++r) a[r] = (f32x4){0.f, 0.f, 0.f, 0.f};
            const LAS float* s = sc + ks * 64;
#pragma unroll 2
            for (int k4 = 0; k4 < 64; k4 += 4) {
                f32x4 w[4];
#pragma unroll
                for (int q = 0; q < 4; ++q) w[q] = __builtin_nontemporal_load((const f32x4*)(Wp + (size_t)(k4 + q) * NMOD));
#pragma unroll
                for (int r = 0; r < 9; ++r) { const f32x4 sv = *(const LAS f32x4*)(s + r * DM + k4);
                    a[r] += w[0] * sv.x; a[r] += w[1] * sv.y; a[r] += w[2] * sv.z; a[r] += w[3] * sv.w; } }
#pragma unroll
            for (int r = 0; r < 9; ++r) *(LAS f32x4*)(red + (ks * 9 + r) * 128 + 4 * cq) = a[r];
            __syncthreads();
            for (int o = tid; o < 9 * 128; o += NTHREADS) { const int r = o >> 7, c2 = o & 127; float sum = 0.f;
#pragma unroll
                for (int q = 0; q < 16; ++q) sum += red[(q * 9 + r) * 128 + c2];
                MOD[((size_t)l * 9 + r) * NMOD + n0 + c2] = sum + P.in[5][l * NMOD + n0 + c2]; }
            __syncthreads();
        }
    }
    {
        float* gc = (float*)(ws + WS_RGC); float* gs = (float*)(ws + WS_RGS); float* mc = (float*)(ws + WS_RMC); float* ms = (float*)(ws + WS_RMS);
        const int gt = blockIdx.x * NTHREADS + tid, NT_ = G * NTHREADS;
        for (int i = gt; i < SEQ * 96; i += NT_) {
            const int pos = i / 96, a = i - pos * 96; const float row = (float)(pos >> 6), col = (float)(pos & 63);
            if (a < 64) { const int fi = a & 31; const float fr = powf(10000.f, -(float)fi / 32.f); const float ang = (a < 32 ? row : col) * fr;
                gc[pos * 64 + a] = cosf(ang); gs[pos * 64 + a] = sinf(ang); }
            else { const int a2 = a - 64, fi = a2 & 15; const float fr = powf(10000.f, -(float)fi / 16.f); const float ang = (a2 < 16 ? row : col) * fr;
                mc[pos * 32 + a2] = cosf(ang); ms[pos * 32 + a2] = sinf(ang); }
        }
        { u32x4* zs = (u32x4*)(ws + WS_SS); for (int i = gt; i < 10 * T / 2; i += NT_) zs[i] = (u32x4){0u, 0u, 0u, 0u}; }
        { u32x4* z1 = (u32x4*)(ws + WS_WD + (size_t)1056 * DM * 2); u32x4* z2 = (u32x4*)(ws + WS_WD + (size_t)1184 * DM * 2);
          for (int i = gt; i < 96 * DM * 2 / 16; i += NT_) { z1[i] = (u32x4){0u, 0u, 0u, 0u}; z2[i] = (u32x4){0u, 0u, 0u, 0u}; } }
    }
    transposes_items(P, lds, 0, 6272, blockIdx.x * NWAVES + wave, G * NWAVES, 0, lane);
    transposes_items(P, lds, 0, 17888, blockIdx.x * NWAVES + wave, G * NWAVES, 1, lane);
}

DI void prenorm_phase(const float* XL, const float* XC, const float* g, const float* scv, bf16_t* XS, u64* SS, bf16_t* XLb, bf16_t* XCb, int G) {
    const int tid = otid(), lane = tid & 63, gw = blockIdx.x * NWAVES + (tid >> 6), NGW = G * NWAVES;
    for (int r0 = gw; r0 < T; r0 += 3 * NGW) {
        const float* xr[3]; int mi[3], rr[3]; bool ok[3]; bf16_t* xb[3];
#pragma unroll
        for (int q = 0; q < 3; ++q) { const int r = r0 + q * NGW; ok[q] = r < T; rr[q] = ok[q] ? r : r0;
            const int b = rr[q] / RPB, w = rr[q] - b * RPB;
            if (w < CTXL) { xr[q] = XC + (size_t)(b * CTXL + w) * DM; xb[q] = XCb + (size_t)(b * CTXL + w) * DM; mi[q] = 8; } else { xr[q] = XL + (size_t)(b * SEQ + w - CTXL) * DM; xb[q] = XLb + (size_t)(b * SEQ + w - CTXL) * DM; mi[q] = b; } }
        f32x4 v[3][4]; float ss[3];
#pragma unroll
        for (int q = 0; q < 3; ++q)
#pragma unroll
            for (int j = 0; j < 4; ++j) v[q][j] = ((const f32x4*)xr[q])[lane + 64 * j];
#pragma unroll
        for (int q = 0; q < 3; ++q) { float a = 0.f;
#pragma unroll
            for (int j = 0; j < 4; ++j) a += (v[q][j].x * v[q][j].x + v[q][j].y * v[q][j].y) + (v[q][j].z * v[q][j].z + v[q][j].w * v[q][j].w);
            ss[q] = a; }
#pragma unroll
        for (int o = 1; o < 64; o <<= 1)
#pragma unroll
            for (int q = 0; q < 3; ++q) ss[q] += __shfl_xor(ss[q], o);
#pragma unroll
        for (int q = 0; q < 3; ++q) if (ok[q]) {
            if (lane == 0) SS[rr[q]] = SSQ_FIX(ss[q]);
#pragma unroll
            for (int j = 0; j < 4; ++j) { const int col = 4 * (lane + 64 * j);
                const f32x4 gv = *(const f32x4*)(g + col), sc = *(const f32x4*)(scv + (size_t)mi[q] * NMOD + col);
                const f32x4 o = v[q][j] * gv * (sc + 1.0f);
                u32x2 w2; w2.x = pk2(o.x, o.y); w2.y = pk2(o.z, o.w);
                *(u32x2*)(XS + (size_t)rr[q] * DM + col) = w2;
                u32x2 w3; w3.x = pk2(v[q][j].x, v[q][j].y); w3.y = pk2(v[q][j].z, v[q][j].w); *(u32x2*)(xb[q] + col) = w3; } }
    }
}
DI void ctxfix_phase(const bf16_t* XCsrc, bf16_t* XC, const float* slab, const float* gate, const float* g, const float* scv, bf16_t* XS, u64* SS, int G) {
    const int tid = otid(), lane = tid & 63, gw = blockIdx.x * NWAVES + (tid >> 6), NGW = G * NWAVES;
    for (int rc = gw; rc < NB * CTXL; rc += NGW) {
        const int b = rc >> 8, w = rc & 255, r = b * RPB + w; bf16_t* xr = XC + (size_t)rc * DM; const bf16_t* xs_ = XCsrc + (size_t)rc * DM;
        f32x4 v[4]; float ss = 0.f;
#pragma unroll
        for (int j = 0; j < 4; ++j) {
            const float* sp = slab + (size_t)((b * 4 + j) * 4) * 65536 + (size_t)w * 256 + 4 * lane;
            const f32x4 p0 = *(const f32x4*)sp, p1 = *(const f32x4*)(sp + 65536), p2 = *(const f32x4*)(sp + 2 * 65536), p3 = *(const f32x4*)(sp + 3 * 65536);
            const u32x2 tx = ((const u32x2*)xs_)[lane + 64 * j]; const f32x4 x0 = {bflo(tx.x), bfhi(tx.x), bflo(tx.y), bfhi(tx.y)}, gt4 = *(const f32x4*)(gate + (size_t)8 * NMOD + 4 * (lane + 64 * j));
            v[j] = x0 + gt4 * ((p0 + p1) + (p2 + p3));
            ss += (v[j].x * v[j].x + v[j].y * v[j].y) + (v[j].z * v[j].z + v[j].w * v[j].w); }
        ss = wave_sum(ss); if (lane == 0) SS[r] = SSQ_FIX(ss);
#pragma unroll
        for (int j = 0; j < 4; ++j) { const int col = 4 * (lane + 64 * j);
            { u32x2 wx; wx.x = pk2(v[j].x, v[j].y); wx.y = pk2(v[j].z, v[j].w); ((u32x2*)xr)[lane + 64 * j] = wx; }
            const f32x4 gv = *(const f32x4*)(g + col), sc = *(const f32x4*)(scv + (size_t)8 * NMOD + col);
            const f32x4 o = v[j] * gv * (sc + 1.0f);
            u32x2 w2; w2.x = pk2(o.x, o.y); w2.y = pk2(o.z, o.w);
            *(u32x2*)(XS + (size_t)r * DM + col) = w2; }
    }
}
DI void shw_phase(unsigned char* ws, LAS unsigned char* lds, int first, int stride, int set, int lo, int hi) {
    const int tid = otid(), lane = tid & 63, w = tid >> 6;
    const float* MOD = (const float*)(ws + WS_MOD);
    LAS float* shl = (LAS float*)lds; LAS float* red = shl + 9 * DM;
    int cur = -1;
    for (int it = lo + first; it < hi; it += stride) {
        const bf16_t* Wt; const float* sh; float* out; int N, c, cid;
        if (!set) {
            if (it < 48) { cid = 0; c = it; Wt = (const bf16_t*)(ws + WS_WCI); sh = MOD; out = (float*)(ws + WS_SHWI); N = 3072; }
            else { cid = 4; c = it - 48; Wt = (const bf16_t*)(ws + WS_WUP); sh = MOD + 3 * DM; out = (float*)(ws + WS_SHWU); N = 5632; }
        } else {
            if (it < 24) { cid = 1; c = it; Wt = (const bf16_t*)(ws + WS_WQKV); sh = MOD + (size_t)1 * 9 * NMOD; out = (float*)(ws + WS_SHWI) + 1 * 9 * 3072; N = 1536; }
            else if (it < 44) { cid = 2; c = it - 24; Wt = (const bf16_t*)(ws + WS_WD); sh = MOD + (size_t)2 * 9 * NMOD; out = (float*)(ws + WS_SHWI) + 2 * 9 * 3072; N = 1280; }
            else if (it < 92) { cid = 3; c = it - 44; Wt = (const bf16_t*)(ws + WS_WCI + SZ_WCI); sh = MOD + (size_t)3 * 9 * NMOD; out = (float*)(ws + WS_SHWI) + 3 * 9 * 3072; N = 3072; }
            else { const int q = it - 92, l = 1 + q / 88; cid = 4 + l; c = q - (l - 1) * 88; Wt = (const bf16_t*)(ws + WS_WUP + l * SZ_WUP); sh = MOD + (size_t)l * 9 * NMOD + 3 * DM; out = (float*)(ws + WS_SHWU) + (size_t)l * 9 * 5632; N = 5632; }
        }
        if (cid != cur) { __syncthreads(); for (int i = tid; i < 9 * DM; i += NTHREADS) shl[i] = sh[(size_t)(i >> 10) * NMOD + (i & 1023)]; cur = cid; __syncthreads(); }
        const u32x4* wp = (const u32x4*)(Wt + (size_t)(c * 64 + lane) * DM + 128 * w);
        float a[9];
#pragma unroll
        for (int mi = 0; mi < 9; ++mi) a[mi] = 0.f;
#pragma unroll 4
        for (int ch = 0; ch < 16; ++ch) { const u32x4 wv = wp[ch];
            const float e0 = bflo(wv.x), e1 = bfhi(wv.x), e2 = bflo(wv.y), e3 = bfhi(wv.y), e4 = bflo(wv.z), e5 = bfhi(wv.z), e6 = bflo(wv.w), e7 = bfhi(wv.w);
#pragma unroll
            for (int mi = 0; mi < 9; ++mi) { const LAS f32x4* sp = (const LAS f32x4*)(shl + mi * DM + 128 * w + 8 * ch); const f32x4 s0 = sp[0], s1 = sp[1];
                a[mi] += (s0.x * e0 + s0.y * e1) + (s0.z * e2 + s0.w * e3) + (s1.x * e4 + s1.y * e5) + (s1.z * e6 + s1.w * e7); } }
#pragma unroll
        for (int mi = 0; mi < 9; ++mi) red[(w * 9 + mi) * 64 + lane] = a[mi];
        __syncthreads();
        for (int o = tid; o < 9 * 64; o += NTHREADS) { const int mi = o >> 6, c2 = o & 63; float sum = 0.f;
#pragma unroll
            for (int q = 0; q < 8; ++q) sum += red[(q * 9 + mi) * 64 + c2];
            out[(size_t)mi * N + c * 64 + c2] = sum; }
        __syncthreads();
    }
}

DI void conv_phase(const bf16_t* __restrict__ BUF1, const float* __restrict__ cw, bf16_t* __restrict__ H, bool latonly, int G) {
    const int gt = blockIdx.x * NTHREADS + otid(), NT_ = G * NTHREADS;
    if ((NT_ & 127) == 0) {
        const int c8 = (gt & 127) * 8, rstep = NT_ >> 7;
        float w0[8], w1[8], w2[8];
#pragma unroll
        for (int q = 0; q < 8; ++q) { w0[q] = cw[c8 + q]; w1[q] = cw[DM + c8 + q]; w2[q] = cw[2 * DM + c8 + q]; }
#pragma unroll 3
        for (int r = gt >> 7; r < T; r += rstep) {
            const int b = r / RPB, w = r - b * RPB;
            if (latonly && w < CTXL) continue;
            const bool hp = !(w == 0 || w == CTXL), hn = !(w == CTXL - 1 || w == RPB - 1);
            const bf16_t* up = BUF1 + (size_t)r * 2048 + 1024 + c8;
            const u32x4 zero = {0u, 0u, 0u, 0u};
            const u32x4 uc = *(const u32x4*)up, um = hp ? *(const u32x4*)(up - 2048) : zero, un = hn ? *(const u32x4*)(up + 2048) : zero;
            const u32x4 bb = *(const u32x4*)(BUF1 + (size_t)r * 2048 + c8);
            u32x4 o;
#pragma unroll
            for (int q = 0; q < 4; ++q) {
                const float z0 = bflo(um[q]) * w0[2 * q] + bflo(uc[q]) * w1[2 * q] + bflo(un[q]) * w2[2 * q];
                const float z1 = bfhi(um[q]) * w0[2 * q + 1] + bfhi(uc[q]) * w1[2 * q + 1] + bfhi(un[q]) * w2[2 * q + 1];
                o[q] = pk2(bflo(bb[q]) * z0, bfhi(bb[q]) * z1);
            }
            *(u32x4*)(H + (size_t)r * DM + c8) = o;
        }
        return;
    }
    for (int idx = gt; idx < T * 128; idx += NT_) {
        const int r = idx >> 7, c8 = (idx & 127) * 8; const int b = r / RPB, w = r - b * RPB;
        if (latonly && w < CTXL) continue;
        const bool hp = !(w == 0 || w == CTXL), hn = !(w == CTXL - 1 || w == RPB - 1);
        const bf16_t* up = BUF1 + (size_t)r * 2048 + 1024 + c8;
        const u32x4 zero = {0u, 0u, 0u, 0u};
        const u32x4 uc = *(const u32x4*)up, um = hp ? *(const u32x4*)(up - 2048) : zero, un = hn ? *(const u32x4*)(up + 2048) : zero;
        const u32x4 bb = *(const u32x4*)(BUF1 + (size_t)r * 2048 + c8);
        u32x4 o;
#pragma unroll
        for (int q = 0; q < 4; ++q) {
            const int ch = c8 + 2 * q;
            const float z0 = bflo(um[q]) * cw[ch] + bflo(uc[q]) * cw[DM + ch] + bflo(un[q]) * cw[2 * DM + ch];
            const float z1 = bfhi(um[q]) * cw[ch + 1] + bfhi(uc[q]) * cw[DM + ch + 1] + bfhi(un[q]) * cw[2 * DM + ch + 1];
            o[q] = pk2(bflo(bb[q]) * z0, bfhi(bb[q]) * z1);
        }
        *(u32x4*)(H + (size_t)r * DM + c8) = o;
    }
}

DI void gqa_qknorm_phase(bf16_t* QKV, const float* qg, const float* kg, const float* cosT, const float* sinT, int G) {
    const int tid = otid(), lane = tid & 63, gw = blockIdx.x * NWAVES + (tid >> 6), NGW = G * NWAVES;
    for (int r = gw; r < T; r += NGW) {
        const int b = r / RPB, w = r - b * RPB; const bool lat = w >= CTXL; const int pos = w - CTXL;
        const float c = lat ? cosT[pos * 64 + lane] : 1.f, s = lat ? sinT[pos * 64 + lane] : 0.f;
        bf16_t* p = QKV + (size_t)r * 1536;
        float x1[10], x2[10], sq[10];
#pragma unroll
        for (int hh = 0; hh < 10; ++hh) { x1[hh] = bf2f(p[hh * 128 + lane]); x2[hh] = bf2f(p[hh * 128 + 64 + lane]); }
#pragma unroll
        for (int hh = 0; hh < 10; ++hh) sq[hh] = x1[hh] * x1[hh] + x2[hh] * x2[hh];
#pragma unroll
        for (int o = 1; o < 64; o <<= 1)
#pragma unroll
            for (int hh = 0; hh < 10; ++hh) sq[hh] += __shfl_xor(sq[hh], o);
        const float qg1 = qg[lane], qg2 = qg[64 + lane], kg1 = kg[lane], kg2 = kg[64 + lane];
#pragma unroll
        for (int hh = 0; hh < 10; ++hh) {
            const float rstd = 1.0f / sqrtf(sq[hh] * (1.f / 128.f) + EPS);
            const float y1 = x1[hh] * rstd * (hh < 8 ? qg1 : kg1), y2 = x2[hh] * rstd * (hh < 8 ? qg2 : kg2);
            p[hh * 128 + lane] = (bf16_t)f2bf(y1 * c - y2 * s); p[hh * 128 + 64 + lane] = (bf16_t)f2bf(y1 * s + y2 * c);
        }
    }
}

DI void mla_norm_phase(const float* C1, const float* qg, const float* kvg, const float* cosT, const float* sinT, bf16_t* CQ, bf16_t* CKV, bf16_t* KPE, int G) {
    const int tid = otid(), lane = tid & 63, gw = blockIdx.x * NWAVES + (tid >> 6), NGW = G * NWAVES;
    for (int r = gw; r < T; r += NGW) {
        const int b = r / RPB, w = r - b * RPB; const bool lat = w >= CTXL; const int pos = w - CTXL;
        const float* cr = C1 + (size_t)r * 1280;
        f32x4 v[3]; float ss = 0.f;
#pragma unroll
        for (int j = 0; j < 3; ++j) { v[j] = ((const f32x4*)cr)[lane + 64 * j]; ss += (v[j].x * v[j].x + v[j].y * v[j].y) + (v[j].z * v[j].z + v[j].w * v[j].w); }
        const float rq = 1.0f / sqrtf(wave_sum(ss) * (1.f / 768.f) + EPS);
#pragma unroll
        for (int j = 0; j < 3; ++j) { const int col = 4 * (lane + 64 * j); const f32x4 gv = *(const f32x4*)(qg + col); const f32x4 o = v[j] * rq * gv;
            u32x2 w2; w2.x = pk2(o.x, o.y); w2.y = pk2(o.z, o.w); *(u32x2*)(CQ + (size_t)r * 768 + col) = w2; }
        const f32x4 kv = ((const f32x4*)(cr + 768))[lane];
        const float rk = 1.0f / sqrtf(wave_sum((kv.x * kv.x + kv.y * kv.y) + (kv.z * kv.z + kv.w * kv.w)) * (1.f / 256.f) + EPS);
        { const f32x4 gv = *(const f32x4*)(kvg + 4 * lane); const f32x4 o = kv * rk * gv;
          u32x2 w2; w2.x = pk2(o.x, o.y); w2.y = pk2(o.z, o.w); *(u32x2*)(CKV + (size_t)r * 256 + 4 * lane) = w2; }
        if (lane < 32) { const float x1 = cr[1024 + lane], x2 = cr[1056 + lane];
            const float c = lat ? cosT[pos * 32 + lane] : 1.f, s = lat ? sinT[pos * 32 + lane] : 0.f;
            KPE[(size_t)r * 64 + lane] = (bf16_t)f2bf(x1 * c - x2 * s); KPE[(size_t)r * 64 + 32 + lane] = (bf16_t)f2bf(x1 * s + x2 * c); }
    }
}

template <int DQK, int LDQ, int LDK, int SDEPTH>
DI void attn_phase(const bf16_t* Q, int qhs, const bf16_t* Kb, const bf16_t* Vb, int khs, int kdiv, const bf16_t* KPE, bf16_t* O, char* lds, int G, int nunits) {
    for (int u = blockIdx.x; u < nunits; u += G) {
        int b, h, qrow, nk;
        if (u < 512) { h = u & 7; const int qb = (u >> 3) & 7; b = u >> 6; qrow = b * RPB + CTXL + qb * 256; nk = RPB; }
        else { const int uc = u - 512; h = uc & 7; b = uc >> 3; qrow = b * RPB; nk = CTXL; }
        const int kvh = h / kdiv; const size_t krow = (size_t)b * RPB;
        att::attn_body<DQK, LDQ, LDK, SDEPTH>(Q + (size_t)qrow * LDQ + h * qhs, Kb + krow * LDK + kvh * khs, Vb + krow * LDK + kvh * khs, KPE + krow * 64,
                                               O + (size_t)qrow * DM + h * 128, nk, lds);
        __syncthreads();
    }
}

#define XB_TMO      128
#define XB_XCNT(j)  (256  + 64 * (j))
#define XB_XSUB(j)  (1280 + 64 * (j))
#define XB_XGEN(j)  (2304 + 64 * (j))
#define XB_TOP      3328
#define XB_TOPGEN   3392
#define XCD_BAR_WORDS 3456
#define XB_SPIN_CAP (1u << 20)
DI unsigned xb_ld(unsigned* p)              { return __hip_atomic_load(p, __ATOMIC_RELAXED, __HIP_MEMORY_SCOPE_AGENT); }
DI unsigned xb_add(unsigned* p, unsigned v) { return __hip_atomic_fetch_add(p, v, __ATOMIC_RELAXED, __HIP_MEMORY_SCOPE_AGENT); }
DI unsigned xb_xcc_id() { return (unsigned)__builtin_amdgcn_s_getreg((3 << 11) | 20) & 0xFu; }
#define XB_SPIN(cond, bar) do { unsigned _sp = 0; while (cond) { __builtin_amdgcn_s_sleep(1); \
    if ((++_sp & 255u) == 0u) { if (xb_ld(&(bar)[XB_TMO])) break; if (_sp > XB_SPIN_CAP) { atomicAdd(&(bar)[XB_TMO], 1u); break; } } } } while (0)
struct XcdBarrier { unsigned* bar; unsigned x; volatile LAS unsigned* st; };
DI XcdBarrier xcd_barrier_post(unsigned* bar, volatile LAS unsigned* st) {
    XcdBarrier b; b.bar = bar; b.x = 0u; b.st = st;
    if (threadIdx.x == 0) { const unsigned x = xb_xcc_id(); st[2] = x; (void)xb_add(&bar[XB_XCNT(x)], 1u); }
    return b;
}
DI void xcd_barrier_complete(unsigned* bar, unsigned x, unsigned& nloc, unsigned& nx) {
    const unsigned G = gridDim.x * gridDim.y * gridDim.z;
    unsigned sum, cnt, mine, sp = 0u;
    for (;;) {
        sum = 0u; cnt = 0u; mine = 0u;
#pragma unroll
        for (unsigned j = 0; j < 16; ++j) { const unsigned c = xb_ld(&bar[XB_XCNT(j)]); sum += c; cnt += (c > 0u) ? 1u : 0u; mine = (j == x) ? c : mine; }
        if (sum == G) break;
        __builtin_amdgcn_s_sleep(1);
        if ((++sp & 255u) == 0u) { if (xb_ld(&bar[XB_TMO])) break; if (sp > XB_SPIN_CAP) { atomicAdd(&bar[XB_TMO], 1u); break; } }
    }
    nloc = mine > 0u ? mine : 1u; nx = cnt > 0u ? cnt : 1u;
}
DI void xcd_barrier(const XcdBarrier& b) {
    asm volatile("s_waitcnt vmcnt(0)" ::: "memory");
    __syncthreads();
    if (threadIdx.x == 0) {
        unsigned* bar = b.bar; asm volatile("" : "+s"(bar));
        __builtin_amdgcn_s_waitcnt(0);
        unsigned nloc = b.st[0], nx = b.st[1]; const unsigned bx = b.st[2];
        if (nloc == 0u) { xcd_barrier_complete(bar, bx, nloc, nx); b.st[0] = nloc; b.st[1] = nx; }
        const unsigned old = xb_add(&bar[XB_XSUB(bx)], 1u);
        const unsigned gen = old / nloc;
        if (old + 1u == (gen + 1u) * nloc) {
            __builtin_amdgcn_fence(__ATOMIC_RELEASE, "agent");
            asm volatile("s_waitcnt vmcnt(0)" ::: "memory");
            const unsigned og = xb_add(&bar[XB_TOP], 1u);
            const unsigned tg = og / nx;
            if (og + 1u == (tg + 1u) * nx) xb_add(&bar[XB_TOPGEN], 1u);
            else XB_SPIN(xb_ld(&bar[XB_TOPGEN]) == tg, bar);
            __builtin_amdgcn_fence(__ATOMIC_ACQUIRE, "agent");
            xb_add(&bar[XB_XGEN(bx)], 1u);
            asm volatile("s_waitcnt vmcnt(0)" ::: "memory");
        } else {
            XB_SPIN(xb_ld(&bar[XB_XGEN(bx)]) == gen, bar);
            __builtin_amdgcn_fence(__ATOMIC_ACQUIRE, "agent");
            asm volatile("s_waitcnt vmcnt(0)" ::: "memory");
        }
    }
    __syncthreads();
}

__global__ void __launch_bounds__(NTHREADS, 2) fwd_megakernel(Params P) {
    extern __shared__ __attribute__((aligned(16))) unsigned char lds_raw[];
    cg::grid_group grid = cg::this_grid();
    LAS unsigned char* lds = (LAS unsigned char*)lds_raw;
    const int G = gridDim.x;
    unsigned char* ws = P.ws;
    volatile LAS unsigned* MISC = (volatile LAS unsigned*)(lds + 131072);
    if (threadIdx.x < 16) MISC[threadIdx.x] = 0u;
    __syncthreads();
    const XcdBarrier xbar = xcd_barrier_post((unsigned*)(ws + WS_CTL), MISC + 8);
#define GRID_SYNC() xcd_barrier(xbar)
    bf16_t* XL = (bf16_t*)(ws + WS_H); bf16_t* XC = (bf16_t*)(ws + WS_XC);
    const float* MOD = (const float*)(ws + WS_MOD);
    bf16_t* H = (bf16_t*)P.out; bf16_t* BUF1 = (bf16_t*)(ws + WS_BUF1); bf16_t* ACT = (bf16_t*)(ws + WS_ACT);

    bf16_t* XS = (bf16_t*)(ws + WS_XS); u64* SS = (u64*)(ws + WS_SS);
    prologue_phase(P, lds, G);
    if (G > 65535) grid.sync();
    GRID_SYNC();
    prenorm_phase(P.in[0], P.in[2], P.in[6], MOD + 1 * DM, XS, SS, XL, XC, G);
    shw_phase(ws, lds, blockIdx.x, G, 0, 0, 136); shw_phase(ws, lds, blockIdx.x, G, 1, 0, 356);
    GRID_SYNC();

    for (int L = 0; L < 4; ++L) {
        const int kind = L % 3, j = L / 3; const bool latonly = (L == 3);
        const bool latout = (L >= 2);
        const bf16_t* srcL = XL; const bf16_t* srcC = XC;
        const float* modL = MOD + (size_t)L * 9 * NMOD;
        const u64* ssA = SS + (size_t)(2 * L) * T; const u64* ssB = SS + (size_t)(2 * L + 1) * T;
        const float* shwI = (const float*)(ws + WS_SHWI) + (size_t)L * 9 * 3072; const float* shwU = (const float*)(ws + WS_SHWU) + (size_t)L * 9 * 5632;
        const bf16_t* Wout;
        if (kind == 0) {
            { pg8::Gemm g{XS, (const bf16_t*)(ws + WS_WCI + j * SZ_WCI), DM, DM}; pg8::Sched S; S.init(latonly, 3072, G, blockIdx.x);
              pg8::Epi<pg8::EK_CONVIN> E{}; E.O = BUF1; E.ldc = 2048; E.ss = ssA; E.shw = shwI; E.shwN = 3072;
              pg8::gemm_phase(lds, g, S, E); }
            GRID_SYNC();
            conv_phase(BUF1, P.in[12] + (size_t)j * 3 * DM, H, latonly, G);
            GRID_SYNC();
            Wout = (const bf16_t*)(ws + WS_WCO + j * SZ_WSQ);
        } else if (kind == 1) {
            { pg8::Gemm g{XS, (const bf16_t*)(ws + WS_WQKV), DM, DM}; pg8::Sched S; S.init(0, 1536, G, blockIdx.x);
              pg8::Epi<pg8::EK_QKV> E{}; E.O = BUF1; E.ldc = 1536; E.ss = ssA; E.shw = shwI; E.shwN = 1536; E.g1 = P.in[17]; E.g2 = P.in[18];
              E.cosT = (const float*)(ws + WS_RGC); E.sinT = (const float*)(ws + WS_RGS); E.xlds = lds + 131072 + 4096;
              pg8::gemm_phase(lds, g, S, E); }
            GRID_SYNC();
            attn_phase<128, 1536, 1536, 2>(BUF1, 128, BUF1 + 1024, BUF1 + 1280, 128, 4, BUF1, H, (char*)lds_raw, G, 576);
            GRID_SYNC();
            Wout = (const bf16_t*)(ws + WS_WGO);
        } else {
            bf16_t* QM = (bf16_t*)(ws + WS_ACT);
            bf16_t* CQ = QM + (size_t)T * 1536; bf16_t* CKV = CQ + (size_t)T * 768; bf16_t* KPE = (bf16_t*)(ws + WS_KPE);
            u64* SSQ = SS + (size_t)8 * T; u64* SSKV = SS + (size_t)9 * T;
            { pg8::Gemm g{XS, (const bf16_t*)(ws + WS_WD), DM, DM}; pg8::Sched S; S.init(0, 1280, G, blockIdx.x);
              pg8::Epi<pg8::EK_MLAD> E{}; E.O = CQ; E.O2 = CKV; E.O3 = KPE; E.g1 = P.in[21]; E.g2 = P.in[24]; E.ssa = SSQ; E.ssb = SSKV;
              E.cosT = (const float*)(ws + WS_RMC); E.sinT = (const float*)(ws + WS_RMS); E.ss = ssA; E.shw = shwI; E.shwN = 1280;
              pg8::gemm_phase(lds, g, S, E); }
            GRID_SYNC();
            { pg8::Gemm g{CQ, (const bf16_t*)(ws + WS_WUQ), 768, 768}; pg8::Sched S; S.init(1, 1536, G, blockIdx.x, 768);
              pg8::Epi<pg8::EK_MLAQ> E{}; E.O = QM; E.ldc = 1536; E.cosT = (const float*)(ws + WS_RMC); E.sinT = (const float*)(ws + WS_RMS); E.ss = SSQ; E.inv_n = 1.f / 768.f;
              pg8::gemm_phase(lds, g, S, E); }
            { pg8::Gemm g{CKV, (const bf16_t*)(ws + WS_WUKV), 256, 256}; pg8::Sched S; S.init(0, 2048, G, blockIdx.x, 256, 1);
              pg8::Epi<pg8::EK_BF16> E{}; E.O = BUF1; E.ldc = 2048; E.ss = SSKV; E.inv_n = 1.f / 256.f;
              pg8::gemm_phase(lds, g, S, E); }
            GRID_SYNC();
            attn_phase<192, 1536, 2048, 1>(QM, 192, BUF1, BUF1 + 128, 256, 1, KPE, H, (char*)lds_raw, G, 512);
            GRID_SYNC();
            Wout = (const bf16_t*)(ws + WS_WMO);
        }
        const bool splitk = !latout && G == 256;
        { pg8::Gemm g{H, Wout, DM, DM};
          pg8::Epi<pg8::EK_RESID> E{}; E.srcL = srcL; E.srcC = srcC; E.dstL = XL; E.dstC = XC; E.gate = modL + 2 * DM; E.slab = (float*)BUF1;
          E.gnext = P.in[7] + L * DM; E.scnext = modL + 4 * DM; E.ssnext = SS + (size_t)(2 * L + 1) * T; E.XS = XS;
          pg8::Sched S; S.init(latout, DM, G, blockIdx.x, DM, 0, splitk); pg8::gemm_phase(lds, g, S, E); }
        GRID_SYNC();
        if (splitk) {
            ctxfix_phase(srcC, XC, (const float*)BUF1, modL + 2 * DM, P.in[7] + L * DM, modL + 4 * DM, XS, SS + (size_t)(2 * L + 1) * T, G);
            GRID_SYNC();
        }
        { pg8::Gemm g{XS, (const bf16_t*)(ws + WS_WUP + L * SZ_WUP), DM, DM}; pg8::Sched S; S.init(latout, 2 * FF, G, blockIdx.x);
          pg8::Epi<pg8::EK_SWIGLU> E{}; E.O = ACT; E.ldc = FF; E.ss = ssB; E.shw = shwU; E.shwN = 5632;
          pg8::gemm_phase(lds, g, S, E); }
        GRID_SYNC();
        { pg8::Gemm g{ACT, (const bf16_t*)(ws + WS_WDN + L * SZ_WDN), FF, FF};
          pg8::Epi<pg8::EK_RESID> E{}; E.srcL = XL; E.srcC = XC; E.dstL = XL; E.dstC = XC; E.gate = modL + 5 * DM; E.slab = (float*)BUF1;
          if (L < 3) { E.gnext = P.in[6] + (L + 1) * DM; E.scnext = MOD + (size_t)(L + 1) * 9 * NMOD + 1 * DM; E.ssnext = SS + (size_t)(2 * L + 2) * T; E.XS = XS; }
          pg8::Sched S; S.init(latout, DM, G, blockIdx.x, FF, 0, splitk); pg8::gemm_phase(lds, g, S, E); }
        GRID_SYNC();
        if (splitk) {
            ctxfix_phase(XC, XC, (const float*)BUF1, modL + 5 * DM, P.in[6] + (L + 1) * DM, MOD + (size_t)(L + 1) * 9 * NMOD + 1 * DM, XS, SS + (size_t)(2 * L + 2) * T, G);
            GRID_SYNC();
        }
    }
    const int ftid = otid(), lane = ftid & 63, gw = blockIdx.x * NWAVES + (ftid >> 6), NGW = G * NWAVES;
    for (int r = gw; r < NB * SEQ; r += 2 * NGW) {
        const int r2 = r + NGW; const bool has2 = r2 < NB * SEQ;
        const bf16_t* xr = XL + (size_t)r * DM; const bf16_t* xr2 = XL + (size_t)(has2 ? r2 : r) * DM; f32x4 v[4], v2[4]; float ss = 0.f, ss2 = 0.f;
#pragma unroll
        for (int q = 0; q < 4; ++q) { const u32x2 t = ((const u32x2*)xr)[lane + 64 * q], t2 = ((const u32x2*)xr2)[lane + 64 * q];
            v[q] = (f32x4){bflo(t.x), bfhi(t.x), bflo(t.y), bfhi(t.y)}; v2[q] = (f32x4){bflo(t2.x), bfhi(t2.x), bflo(t2.y), bfhi(t2.y)}; }
#pragma unroll
        for (int q = 0; q < 4; ++q) { ss += (v[q].x * v[q].x + v[q].y * v[q].y) + (v[q].z * v[q].z + v[q].w * v[q].w); ss2 += (v2[q].x * v2[q].x + v2[q].y * v2[q].y) + (v2[q].z * v2[q].z + v2[q].w * v2[q].w); }
#pragma unroll
        for (int o = 1; o < 64; o <<= 1) { ss += __shfl_xor(ss, o); ss2 += __shfl_xor(ss2, o); }
        const float rstd = 1.0f / sqrtf(ss * (1.f / DM) + EPS), rstd2 = 1.0f / sqrtf(ss2 * (1.f / DM) + EPS);
        float* orow = P.out + (size_t)r * DM; float* orow2 = P.out + (size_t)(has2 ? r2 : r) * DM;
#pragma unroll
        for (int q = 0; q < 4; ++q) { const f32x4 gv = ((const f32x4*)P.in[27])[lane + 64 * q]; ((f32x4*)orow)[lane + 64 * q] = v[q] * rstd * gv; if (has2) ((f32x4*)orow2)[lane + 64 * q] = v2[q] * rstd2 * gv; }
    }
}

extern "C" void kernel_launch(void* const* d_in, const int* in_sizes, int n_in, void* d_out, int out_size, void* d_ws, size_t ws_size, hipStream_t stream) {
    static int grid = 0;
    if (grid == 0) {
        if (n_in != 28 || in_sizes[0] != NB * SEQ * DM || out_size != NB * SEQ * DM || ws_size < WS_END) {
            fprintf(stderr, "kernel_launch: shape/workspace mismatch: n_in %d in0 %d out %d ws %zu (need %zu)\n", n_in, n_in > 0 ? in_sizes[0] : -1, out_size, ws_size, (size_t)WS_END); grid = -1; return; }
        int dev = 0, cus = 0, per_cu = 0;
        if (hipGetDevice(&dev) != hipSuccess || hipDeviceGetAttribute(&cus, hipDeviceAttributeMultiprocessorCount, dev) != hipSuccess) { grid = -1; return; }
        if (hipFuncSetAttribute((const void*)fwd_megakernel, hipFuncAttributeMaxDynamicSharedMemorySize, LDS_BYTES) != hipSuccess) { fprintf(stderr, "kernel_launch: hipFuncSetAttribute failed\n"); grid = -1; return; }
        if (hipOccupancyMaxActiveBlocksPerMultiprocessor(&per_cu, (const void*)fwd_megakernel, NTHREADS, LDS_BYTES) != hipSuccess || per_cu < 1) { fprintf(stderr, "kernel_launch: occupancy query says %d\n", per_cu); per_cu = 1; }
        (void)hipGetLastError();
        grid = cus;
    }
    if (grid < 0) return;
    Params p{};
    for (int i = 0; i < 28; ++i) p.in[i] = (const float*)d_in[i];
    p.out = (float*)d_out; p.ws = (unsigned char*)d_ws;
    if (hipMemsetAsync((char*)d_ws + WS_CTL, 0, CTL_BYTES, stream) != hipSuccess) { fprintf(stderr, "kernel_launch: memset failed\n"); return; }
    void* args[] = {&p};
    hipError_t e = hipLaunchCooperativeKernel((const void*)fwd_megakernel, dim3(grid), dim3(NTHREADS), args, LDS_BYTES, stream);
    if (e != hipSuccess) fprintf(stderr, "kernel_launch: cooperative launch failed: %s (grid %d)\n", hipGetErrorString(e), grid);
}
```

```cpp
#include <hip/hip_runtime.h>
#include <hip/hip_cooperative_groups.h>
#include <cstdio>
#include <cstdint>
namespace cg = cooperative_groups;

#define LAS __attribute__((address_space(3)))
typedef unsigned short bf16_t;
typedef short bf16x8 __attribute__((ext_vector_type(8)));
typedef short s16x4 __attribute__((ext_vector_type(4)));
typedef float f32x4 __attribute__((ext_vector_type(4)));
typedef float f32x16 __attribute__((ext_vector_type(16)));
typedef unsigned u32x4 __attribute__((ext_vector_type(4)));
typedef unsigned u32x2 __attribute__((ext_vector_type(2)));
typedef unsigned long long u64;
#define SSQ_FIX(x) __float2ull_rn((x) * 1048576.f)
#define SSQ_UNFIX(u) ((float)(u) * (1.f / 1048576.f))
#define DI __device__ __forceinline__

constexpr int NB = 8, SEQ = 2048, DM = 1024, CTXL = 256, RPB = SEQ + CTXL  , T = NB * RPB  ;
constexpr int FF = 2816, NMOD = 6 * DM;
constexpr float EPS = 1e-6f;
constexpr int NTHREADS = 512, NWAVES = 8;

constexpr size_t AL(size_t x) { return (x + 255) / 256 * 256; }
constexpr size_t WS_XC = 0;
constexpr size_t WS_MOD = WS_XC + AL((size_t)NB * CTXL * DM * 4);
constexpr size_t WS_RGC = WS_MOD + AL((size_t)4 * 9 * NMOD * 4);
constexpr size_t WS_RGS = WS_RGC + AL((size_t)SEQ * 64 * 4);
constexpr size_t WS_RMC = WS_RGS + AL((size_t)SEQ * 64 * 4);
constexpr size_t WS_RMS = WS_RMC + AL((size_t)SEQ * 32 * 4);
constexpr size_t WS_H = WS_RMS + AL((size_t)SEQ * 32 * 4);
constexpr size_t WS_BUF1 = WS_H + AL((size_t)T * DM * 2);
constexpr size_t WS_ACT = WS_BUF1 + AL((size_t)T * 2048 * 2);
constexpr size_t WS_CQ = WS_ACT + AL((size_t)T * FF * 2);
constexpr size_t WS_CKV = WS_CQ + AL((size_t)T * 768 * 2);
constexpr size_t WS_KPE = WS_CKV + AL((size_t)T * 256 * 2);
constexpr size_t WS_WUP = WS_KPE + AL((size_t)T * 64 * 2);
constexpr size_t SZ_WUP = (size_t)2 * FF * DM * 2;
constexpr size_t WS_WDN = WS_WUP + 4 * SZ_WUP;
constexpr size_t SZ_WDN = (size_t)DM * FF * 2;
constexpr size_t WS_WCI = WS_WDN + 4 * SZ_WDN;
constexpr size_t SZ_WCI = (size_t)3072 * DM * 2;
constexpr size_t WS_WCO = WS_WCI + 2 * SZ_WCI;
constexpr size_t SZ_WSQ = (size_t)DM * DM * 2;
constexpr size_t WS_WQKV = WS_WCO + 2 * SZ_WSQ;
constexpr size_t WS_WGO = WS_WQKV + (size_t)1536 * DM * 2;
constexpr size_t WS_WD = WS_WGO + SZ_WSQ;
constexpr size_t WS_WUQ = WS_WD + (size_t)1280 * DM * 2;
constexpr size_t WS_WUKV = WS_WUQ + (size_t)1536 * 768 * 2;
constexpr size_t WS_WMO = WS_WUKV + (size_t)2048 * 256 * 2;
constexpr size_t WS_SS = WS_WMO + SZ_WSQ;
constexpr size_t WS_SHWI = WS_SS + AL((size_t)10 * T * 8);
constexpr size_t WS_SHWU = WS_SHWI + AL((size_t)4 * 9 * 3072 * 4);
constexpr size_t WS_CTL = WS_SHWU + AL((size_t)4 * 9 * 5632 * 4);
constexpr size_t CTL_BYTES = 16384;
constexpr size_t WS_END = WS_CTL + CTL_BYTES;
static_assert((size_t)T * (1536 + 768 + 256) * 2 <= (size_t)T * FF * 2, "QM | CQ | CKV fit in the FFN hidden buffer");
constexpr size_t WS_XS = WS_CQ;
static_assert(WS_CKV == WS_CQ + (size_t)T * 768 * 2 && WS_KPE == WS_CKV + (size_t)T * 256 * 2, "CQ|CKV contiguous = XS");
static_assert(WS_END <= (size_t)400 * 1000 * 1000, "workspace budget");

constexpr int LDS_BYTES = 131072 + 4096 + 4096;

struct Params { const float* in[28]; float* out; unsigned char* ws; };

DI unsigned f2bf(float f) { unsigned u = __float_as_uint(f); return (u + 0x7fffu + ((u >> 16) & 1u)) >> 16; }
DI unsigned pk2(float lo, float hi) { return f2bf(lo) | (f2bf(hi) << 16); }
DI float bf2f(unsigned short b) { return __uint_as_float(((unsigned)b) << 16); }
DI float bflo(unsigned w) { return __uint_as_float(w << 16); }
DI float bfhi(unsigned w) { return __uint_as_float(w & 0xffff0000u); }
DI unsigned cvt_pk_bf16(float lo, float hi) { unsigned r; asm volatile("v_cvt_pk_bf16_f32 %0, %1, %2" : "=v"(r) : "v"(lo), "v"(hi)); return r; }
DI float wave_sum(float v) {
#pragma unroll
    for (int o = 1; o < 64; o <<= 1) v += __shfl_xor(v, o);
    return v;
}
DI int otid() { int t = threadIdx.x; asm volatile("" : "+v"(t)); return t; }
#define LDS_WAIT() asm volatile("s_waitcnt lgkmcnt(0)" ::: "memory")

namespace pg8 {
constexpr int BM = 256, BK = 64, HALF = 128, HTB = HALF * BK * 2, STAGE_BYTES = 8 * HTB, NXCD = 8, WGM = 8;
DI int lds_byte(int r, int c) { const int st = (r >> 4) * 2 + (c >> 5), rr = r & 15, cc = c & 31, ob = rr * 64 + cc * 2; return st * 1024 + (ob ^ (((ob >> 9) & 1) << 5)); }
DI void stage_rc(int b, int& R, int& C) { const int st = b / 1024, sb = b % 1024, swz = sb ^ (((sb >> 9) & 1) << 5); R = (st >> 1) * 16 + swz / 64; C = (st & 1) * 32 + (swz % 64) / 2; }
DI int perm32(int rho) { const int n = rho >> 4, i = rho & 15; return 8 * (i >> 2) + 4 * n + (i & 3); }

struct Unit { int pm, pn, k0, nt, part; };
struct Gemm { const bf16_t* A; const bf16_t* Bt; int lda, K; };

struct Sched {
    int nM, nN, nwg, G, c, latonly, ntk, skew, split;
    DI void init(int latonly_, int N, int G_, int c_, int K_ = DM, int skew_ = 0, int split_ = 0) { latonly = latonly_; nM = latonly_ ? 64 : 72; nN = N / BM; nwg = nM * nN; G = G_; c = c_; ntk = K_ / BK; skew = skew_; split = split_; }
    DI bool next(int i, Unit& u) const {
        long L = (long)i * G + c;
        if (split) {
            if (L >= 256 + 128) return false;
            if (L < 256) { int wgid = (int)L; { const int q = 256 / NXCD, xcd = wgid % NXCD, off = wgid / NXCD; wgid = xcd * q + off; }
                const int nig = WGM * 4, gid = wgid / nig, fm = gid * WGM; const int pm = fm + ((wgid % nig) % WGM); u.pn = (wgid % nig) / WGM;
                u.pm = (pm >> 3) * 9 + 1 + (pm & 7); u.k0 = 0; u.nt = ntk; u.part = 0; }
            else { const int idx = (int)L - 256, tile = idx >> 2, seg = idx & 3; u.pm = (tile >> 2) * 9; u.pn = tile & 3; u.part = 1 + seg;
                if (ntk == 44) { u.k0 = (seg >> 1) * 22 + (seg & 1) * 12; u.nt = (seg & 1) ? 10 : 12; } else { u.k0 = seg * 4; u.nt = 4; } }
            return true;
        }
        if (skew && G == 256) {
            if (c < 128) { if (i > 0) return false; L = c; } else L = c + 128 * i; }
        if (L >= nwg) return false;
        u.k0 = 0; u.nt = ntk; u.part = 0;
        int wgid = (int)L; { const int q = nwg / NXCD, r = nwg % NXCD, xcd = wgid % NXCD, off = wgid / NXCD; wgid = (xcd < r ? xcd * (q + 1) : r * (q + 1) + (xcd - r) * q) + off; }
        const int nig = WGM * nN, gid = wgid / nig, fm = gid * WGM, gsz = (nM - fm) < WGM ? (nM - fm) : WGM;
        int pm = fm + ((wgid % nig) % gsz); u.pn = (wgid % nig) / gsz;
        u.pm = latonly ? (pm >> 3) * 9 + 1 + (pm & 7) : pm; return true;
    }
    DI void a_ready(const Unit&) const {}
    DI void done(const Unit&) const {}
};

template <class Epi, class SchedT>
DI void gemm_phase(LAS unsigned char* lds, const Gemm g, const SchedT& S, const Epi& E) {
    const int tid = otid(), wid = __builtin_amdgcn_readfirstlane(tid >> 6), lane = tid & 63, wr = wid >> 2, wc = wid & 3, fr = lane & 15, fq = lane >> 4;
    const int K = g.K, lda = g.lda;
    unsigned voffA[2], voffB[2];
#pragma unroll
    for (int i = 0; i < 2; ++i) { int R, C; stage_rc(tid * 16 + i * 8192, R, C); const int Rb = Epi::PERM ? ((R & ~31) + perm32(R & 31)) : R;
        voffA[i] = (unsigned)(R * lda + C) * 2u; voffB[i] = (unsigned)(Rb * K + C) * 2u; }
    const size_t kstep = (size_t)(BK * 2);
    const size_t hstepA = (size_t)HALF * lda * 2, hstepB = (size_t)HALF * K * 2;
    const size_t tstepA = 2 * hstepA, tstepB = 2 * hstepB;
    const unsigned ldsw = (unsigned)wid * 1024u;
    const int aoff = lds_byte(wr * 64 + fr, fq * 8), boff = lds_byte(wc * 32 + fr, fq * 8);
#define PG8_SA(b, h) (((b) * 2 + (h)) * HTB)
#define PG8_SB(b, h) ((4 + (b) * 2 + (h)) * HTB)
#define PG8_STAGE(bufoff, gbase, voff) do { _Pragma("unroll") for (int _i = 0; _i < 2; ++_i) \
        __builtin_amdgcn_global_load_lds((const unsigned*)((const char*)(gbase) + (voff)[_i]), (LAS unsigned*)(lds + (bufoff) + ldsw + _i * 8192), 16, 0, 0); } while (0)
#define PG8_LDA(dst, b, h) do { _Pragma("unroll") for (int m = 0; m < 4; ++m) _Pragma("unroll") for (int k = 0; k < 2; ++k) dst[m][k] = *(const LAS bf16x8*)(lds + PG8_SA(b, h) + aoff + m * 2048 + k * 1024); } while (0)
#define PG8_LDB(dst, b, h) do { _Pragma("unroll") for (int n = 0; n < 2; ++n) _Pragma("unroll") for (int k = 0; k < 2; ++k) dst[n][k] = *(const LAS bf16x8*)(lds + PG8_SB(b, h) + boff + n * 2048 + k * 1024); } while (0)
#define PG8_MMA(ai, bj, At, Bt) do { __builtin_amdgcn_s_setprio(1); _Pragma("unroll") for (int m = 0; m < 4; ++m) _Pragma("unroll") for (int n = 0; n < 2; ++n) _Pragma("unroll") for (int k = 0; k < 2; ++k) \
        acc[ai][bj][m][n] = __builtin_amdgcn_mfma_f32_16x16x32_bf16(Bt[n][k], At[m][k], acc[ai][bj][m][n], 0, 0, 0); __builtin_amdgcn_s_setprio(0); } while (0)
#define PG8_WAIT_V(n) asm volatile("s_waitcnt vmcnt(" #n ")" ::: "memory")
#define PG8_WAIT_L(n) asm volatile("s_waitcnt lgkmcnt(" #n ")" ::: "memory")
#define PG8_BAR __builtin_amdgcn_s_barrier()
#define PG8_SCHED __builtin_amdgcn_sched_barrier(0)
    Unit cur, nxt; int ui = 0;
    if (!S.next(0, cur)) return;
    f32x4 acc[2][2][4][2];
#pragma unroll
    for (int a = 0; a < 2; ++a)
#pragma unroll
        for (int b = 0; b < 2; ++b)
#pragma unroll
            for (int m = 0; m < 4; ++m)
#pragma unroll
                for (int n = 0; n < 2; ++n) acc[a][b][m][n] = (f32x4){0.f, 0.f, 0.f, 0.f};
    bf16x8 At[4][2], B0[2][2], B1[2][2];
    const char* cA = (const char*)g.A + (size_t)cur.pm * tstepA + (size_t)cur.k0 * kstep; const char* cB = (const char*)g.Bt + (size_t)cur.pn * tstepB + (size_t)cur.k0 * kstep;
    S.a_ready(cur);
    PG8_STAGE(PG8_SB(0, 0), cB, voffB); PG8_STAGE(PG8_SB(0, 1), cB + hstepB, voffB); PG8_STAGE(PG8_SA(0, 0), cA, voffA); PG8_STAGE(PG8_SA(0, 1), cA + hstepA, voffA);
    if (wr == 1) PG8_BAR;
    PG8_WAIT_V(2); PG8_BAR;
    PG8_STAGE(PG8_SB(1, 0), cB + kstep, voffB); PG8_STAGE(PG8_SA(1, 0), cA + kstep, voffA); PG8_STAGE(PG8_SB(1, 1), cB + hstepB + kstep, voffB);
    PG8_WAIT_V(6); PG8_BAR;
    for (;;) {
        const bool has_next = S.next(ui + 1, nxt);
        const char* nA = has_next ? (const char*)g.A + (size_t)nxt.pm * tstepA + (size_t)nxt.k0 * kstep : cA; const char* nB = has_next ? (const char*)g.Bt + (size_t)nxt.pn * tstepB + (size_t)nxt.k0 * kstep : cB;
        const int nt = cur.nt;
        for (int t = 0; t < nt; t += 2) {
            const bool last = (t == nt - 2);
            const char* a1 = cA + (size_t)(t + 1) * kstep;
            const char* a2 = last ? nA : cA + (size_t)(t + 2) * kstep; const char* b2 = last ? nB : cB + (size_t)(t + 2) * kstep;
            const char* a3 = a2 + kstep; const char* b3 = b2 + kstep;
            if (last && has_next) S.a_ready(nxt);
            PG8_LDB(B0, 0, 0); PG8_LDB(B1, 0, 1); PG8_SCHED; PG8_LDA(At, 0, 0); PG8_STAGE(PG8_SA(1, 1), a1 + hstepA, voffA);
            PG8_WAIT_V(8); PG8_WAIT_L(0); PG8_BAR; PG8_MMA(0, 0, At, B0); PG8_MMA(0, 1, At, B1); PG8_BAR; PG8_SCHED;
            PG8_LDA(At, 0, 1); PG8_STAGE(PG8_SB(0, 0), b2, voffB); PG8_STAGE(PG8_SB(0, 1), b2 + hstepB, voffB); PG8_STAGE(PG8_SA(0, 0), a2, voffA);
            PG8_WAIT_V(8); PG8_WAIT_L(0); PG8_BAR; PG8_MMA(1, 0, At, B0); PG8_MMA(1, 1, At, B1); PG8_BAR; PG8_SCHED;
            PG8_LDB(B0, 1, 0); PG8_LDB(B1, 1, 1); PG8_SCHED; PG8_LDA(At, 1, 0); PG8_STAGE(PG8_SA(0, 1), a2 + hstepA, voffA);
            PG8_WAIT_V(8); PG8_WAIT_L(0); PG8_BAR; PG8_MMA(0, 0, At, B0); PG8_MMA(0, 1, At, B1); PG8_BAR; PG8_SCHED;
            PG8_LDA(At, 1, 1); PG8_STAGE(PG8_SB(1, 0), b3, voffB); PG8_STAGE(PG8_SB(1, 1), b3 + hstepB, voffB); PG8_STAGE(PG8_SA(1, 0), a3, voffA);
            PG8_WAIT_V(8); PG8_WAIT_L(0); PG8_BAR; PG8_MMA(1, 0, At, B0); PG8_MMA(1, 1, At, B1); PG8_BAR; PG8_SCHED;
        }
        if (wr == 0) PG8_BAR;
        E(acc, cur, wr, wc, fr, fq); S.done(cur);
        if (!has_next) break;
#pragma unroll
        for (int a = 0; a < 2; ++a)
#pragma unroll
            for (int b = 0; b < 2; ++b)
#pragma unroll
                for (int m = 0; m < 4; ++m)
#pragma unroll
                    for (int n = 0; n < 2; ++n) acc[a][b][m][n] = (f32x4){0.f, 0.f, 0.f, 0.f};
        cur = nxt; cA = nA; cB = nB; ++ui;
        if (wr == 1) PG8_BAR;
    }
    PG8_WAIT_V(0);
    PG8_BAR;
#undef PG8_SA
#undef PG8_SB
#undef PG8_STAGE
#undef PG8_LDA
#undef PG8_LDB
#undef PG8_MMA
#undef PG8_WAIT_V
#undef PG8_WAIT_L
#undef PG8_BAR
#undef PG8_SCHED
}

enum { EK_CONVIN = 0, EK_RESID = 1, EK_BF16 = 2, EK_SWIGLU = 3, EK_F32 = 4, EK_MLAQ = 5, EK_MLAD = 6, EK_QKV = 7 };
typedef f32x4 AccT[2][2][4][2];

template <int KIND> struct Epi {
    static constexpr bool PERM = (KIND != EK_F32);
    bf16_t* O; int ldc;
    float* Cf;
    const bf16_t* srcL; const bf16_t* srcC; bf16_t* dstL; bf16_t* dstC; const float* gate;
    const float* cosT; const float* sinT;
    float inv_n;
    LAS unsigned char* xlds;
    float* slab;
    bf16_t* O2; bf16_t* O3; const float* g1; const float* g2; u64* ssa; u64* ssb;
    const u64* ss; const float* shw; int shwN;
    const float* gnext; const float* scnext; u64* ssnext; bf16_t* XS;

    DI void coefs(int mi, int row0, int colbase, int nstep, float (&rs)[2][4], f32x4 (&sw)[2][2]) const {
        const float in_ = inv_n > 0.f ? inv_n : (1.f / DM);
#pragma unroll
        for (int ai = 0; ai < 2; ++ai)
#pragma unroll
            for (int m = 0; m < 4; ++m) rs[ai][m] = ss ? 1.0f / sqrtf(SSQ_UNFIX(ss[row0 + ai * HALF + m * 16]) * in_ + EPS) : 1.f;
#pragma unroll
        for (int bj = 0; bj < 2; ++bj)
#pragma unroll
            for (int n = 0; n < 2; ++n) sw[bj][n] = shw ? *(const f32x4*)(shw + (size_t)mi * shwN + colbase + bj * HALF + n * nstep) : (f32x4){0.f, 0.f, 0.f, 0.f};
    }

    DI void operator()(const AccT& acc, const Unit& u, int wr, int wc, int fr, int fq) const {
        const int row0 = u.pm * BM + wr * 64 + fr;
        const int mi_ = (u.pm % 9 == 0) ? 8 : u.pm / 9;
        if constexpr (KIND == EK_RESID) {
            const int b = u.pm / 9, tq = u.pm - b * 9, mi = tq == 0 ? 8 : b;
            const size_t rowbase = tq == 0 ? (size_t)b * CTXL : (size_t)b * SEQ + (size_t)(tq - 1) * 256;
            const bf16_t* src = tq == 0 ? srcC : srcL; bf16_t* dst = tq == 0 ? dstC : dstL;
            const int col0 = u.pn * BM + wc * 32 + 8 * fq;
            if (u.part) {
                float* sp = slab + (size_t)((b * 4 + u.pn) * 4 + (u.part - 1)) * 65536 + (size_t)(wr * 64 + fr) * 256 + wc * 32 + 8 * fq;
#pragma unroll
                for (int ai = 0; ai < 2; ++ai)
#pragma unroll
                    for (int m = 0; m < 4; ++m)
#pragma unroll
                        for (int bj = 0; bj < 2; ++bj)
#pragma unroll
                            for (int n = 0; n < 2; ++n) *(f32x4*)(sp + (ai * HALF + m * 16) * 256 + bj * HALF + n * 4) = acc[ai][bj][m][n];
                return;
            }
            f32x4 gv[2][2], gsv[2][2]; const bool fuse = gnext != nullptr;
#pragma unroll
            for (int bj = 0; bj < 2; ++bj)
#pragma unroll
                for (int n = 0; n < 2; ++n) { gv[bj][n] = *(const f32x4*)(gate + (size_t)mi * NMOD + col0 + bj * HALF + n * 4);
                    if (fuse) { const f32x4 g4 = *(const f32x4*)(gnext + col0 + bj * HALF + n * 4), s4 = *(const f32x4*)(scnext + (size_t)mi * NMOD + col0 + bj * HALF + n * 4); gsv[bj][n] = g4 * (s4 + 1.0f); }
                    else gsv[bj][n] = (f32x4){0.f, 0.f, 0.f, 0.f}; }
            float sq[2][4];
#pragma unroll
            for (int ai = 0; ai < 2; ++ai) {
                    u32x4 xv[4][2];
#pragma unroll
                    for (int mm = 0; mm < 4; ++mm)
#pragma unroll
                        for (int bj = 0; bj < 2; ++bj) xv[mm][bj] = *(const u32x4*)(src + (rowbase + wr * 64 + fr + ai * HALF + mm * 16) * DM + col0 + bj * HALF);
#pragma unroll
                    for (int m = 0; m < 4; ++m) { const size_t off = (rowbase + wr * 64 + fr + ai * HALF + m * 16) * DM + col0; float sacc = 0.f;
                        bf16_t* xsp = XS + (size_t)(row0 + ai * HALF + m * 16) * DM + col0;
#pragma unroll
                        for (int bj = 0; bj < 2; ++bj) { const u32x4 t = xv[m][bj]; u32x4 wx, w2;
#pragma unroll
                            for (int n = 0; n < 2; ++n) {
                                const f32x4 x0 = {bflo(t[2 * n]), bfhi(t[2 * n]), bflo(t[2 * n + 1]), bfhi(t[2 * n + 1])};
                                const f32x4 xn = x0 + gv[bj][n] * acc[ai][bj][m][n];
                                wx[2 * n] = cvt_pk_bf16(xn.x, xn.y); wx[2 * n + 1] = cvt_pk_bf16(xn.z, xn.w);
                                sacc += (xn.x * xn.x + xn.y * xn.y) + (xn.z * xn.z + xn.w * xn.w); const f32x4 xs = xn * gsv[bj][n];
                                w2[2 * n] = cvt_pk_bf16(xs.x, xs.y); w2[2 * n + 1] = cvt_pk_bf16(xs.z, xs.w); }
                            *(u32x4*)(dst + off + bj * HALF) = wx;
                            if (fuse) *(u32x4*)(xsp + bj * HALF) = w2; }
                        sq[ai][m] = sacc; }
                }
            if (fuse) {
#pragma unroll
                for (int ai = 0; ai < 2; ++ai)
#pragma unroll
                    for (int m = 0; m < 4; ++m) { float t = sq[ai][m]; t += __shfl_xor(t, 16); t += __shfl_xor(t, 32);
                        if (fq == 0) atomicAdd(ssnext + row0 + ai * HALF + m * 16, SSQ_FIX(t)); }
            }
        } else if constexpr (KIND == EK_F32) {
            const int col0 = u.pn * BM + wc * 32 + 4 * fq;
            float rs[2][4]; f32x4 sw[2][2]; coefs(mi_, row0, col0, 16, rs, sw);
#pragma unroll
            for (int ai = 0; ai < 2; ++ai)
#pragma unroll
                for (int m = 0; m < 4; ++m) { float* rowp = Cf + (size_t)(row0 + ai * HALF + m * 16) * ldc + col0;
#pragma unroll
                    for (int bj = 0; bj < 2; ++bj)
#pragma unroll
                        for (int n = 0; n < 2; ++n) *(f32x4*)(rowp + bj * HALF + n * 16) = acc[ai][bj][m][n] * rs[ai][m] + sw[bj][n]; }
        } else if constexpr (KIND == EK_BF16) {
            const int col0 = u.pn * BM + wc * 32 + 8 * fq;
            float rs[2][4]; f32x4 sw[2][2]; coefs(mi_, row0, col0, 4, rs, sw);
#pragma unroll
            for (int ai = 0; ai < 2; ++ai)
#pragma unroll
                for (int m = 0; m < 4; ++m) { bf16_t* rowp = O + (size_t)(row0 + ai * HALF + m * 16) * ldc + col0;
#pragma unroll
                    for (int bj = 0; bj < 2; ++bj) { const f32x4 v0 = acc[ai][bj][m][0] * rs[ai][m] + sw[bj][0], v1 = acc[ai][bj][m][1] * rs[ai][m] + sw[bj][1];
                        u32x4 w; w.x = cvt_pk_bf16(v0[0], v0[1]); w.y = cvt_pk_bf16(v0[2], v0[3]); w.z = cvt_pk_bf16(v1[0], v1[1]); w.w = cvt_pk_bf16(v1[2], v1[3]);
                        *(u32x4*)(rowp + bj * HALF) = w; } }
        } else if constexpr (KIND == EK_CONVIN) {
            float rs[2][4]; f32x4 sw[2][2]; coefs(mi_, row0, u.pn * BM + wc * 32 + 8 * fq, 4, rs, sw);
            if (u.pn < 4) {
                const int col0 = u.pn * BM + wc * 32 + 8 * fq;
#pragma unroll
                for (int ai = 0; ai < 2; ++ai)
#pragma unroll
                    for (int m = 0; m < 4; ++m) { bf16_t* rowp = O + (size_t)(row0 + ai * HALF + m * 16) * 2048 + col0;
#pragma unroll
                        for (int bj = 0; bj < 2; ++bj) { const f32x4 v0 = acc[ai][bj][m][0] * rs[ai][m] + sw[bj][0], v1 = acc[ai][bj][m][1] * rs[ai][m] + sw[bj][1];
                            u32x4 w; w.x = cvt_pk_bf16(v0[0], v0[1]); w.y = cvt_pk_bf16(v0[2], v0[3]); w.z = cvt_pk_bf16(v1[0], v1[1]); w.w = cvt_pk_bf16(v1[2], v1[3]);
                            *(u32x4*)(rowp + bj * HALF) = w; } }
            } else {
                const int col0 = 1024 + (u.pn - 4) * HALF + wc * 32 + 8 * fq;
#pragma unroll
                for (int ai = 0; ai < 2; ++ai)
#pragma unroll
                    for (int m = 0; m < 4; ++m) { bf16_t* rowp = O + (size_t)(row0 + ai * HALF + m * 16) * 2048 + col0;
                        const f32x4 v0 = (acc[ai][0][m][0] * rs[ai][m] + sw[0][0]) * (acc[ai][1][m][0] * rs[ai][m] + sw[1][0]);
                        const f32x4 v1 = (acc[ai][0][m][1] * rs[ai][m] + sw[0][1]) * (acc[ai][1][m][1] * rs[ai][m] + sw[1][1]);
                        u32x4 w; w.x = cvt_pk_bf16(v0[0], v0[1]); w.y = cvt_pk_bf16(v0[2], v0[3]); w.z = cvt_pk_bf16(v1[0], v1[1]); w.w = cvt_pk_bf16(v1[2], v1[3]);
                        *(u32x4*)rowp = w; }
            }
        } else if constexpr (KIND == EK_SWIGLU) {
            const int col0 = u.pn * HALF + wc * 32 + 8 * fq;
            float rs[2][4]; f32x4 sw[2][2]; coefs(mi_, row0, u.pn * BM + wc * 32 + 8 * fq, 4, rs, sw);
#pragma unroll
            for (int ai = 0; ai < 2; ++ai)
#pragma unroll
                for (int m = 0; m < 4; ++m) { bf16_t* rowp = O + (size_t)(row0 + ai * HALF + m * 16) * FF + col0;
                    f32x4 v[2];
#pragma unroll
                    for (int n = 0; n < 2; ++n) { const f32x4 a = acc[ai][0][m][n] * rs[ai][m] + sw[0][n], bb = acc[ai][1][m][n] * rs[ai][m] + sw[1][n];
                        const f32x4 t = a * (-1.4426950408889634f); f32x4 e;
                        e.x = __builtin_amdgcn_exp2f(t.x); e.y = __builtin_amdgcn_exp2f(t.y); e.z = __builtin_amdgcn_exp2f(t.z); e.w = __builtin_amdgcn_exp2f(t.w);
                        const f32x4 d = e + 1.0f; f32x4 r;
                        r.x = __builtin_amdgcn_rcpf(d.x); r.y = __builtin_amdgcn_rcpf(d.y); r.z = __builtin_amdgcn_rcpf(d.z); r.w = __builtin_amdgcn_rcpf(d.w);
                        v[n] = (a * bb) * r; }
                    u32x4 w; w.x = cvt_pk_bf16(v[0][0], v[0][1]); w.y = cvt_pk_bf16(v[0][2], v[0][3]); w.z = cvt_pk_bf16(v[1][0], v[1][1]); w.w = cvt_pk_bf16(v[1][2], v[1][3]);
                    *(u32x4*)rowp = w; }
        } else if constexpr (KIND == EK_QKV) {
            float rs[2][4]; f32x4 sw[2][2]; coefs(mi_, row0, u.pn * BM + wc * 32 + 8 * fq, 4, rs, sw);
            LAS float* xch = (LAS float*)xlds;
            const int wid8 = wr * 4 + wc;
            f32x4 v[2][4][2][2];
#pragma unroll
            for (int ai = 0; ai < 2; ++ai)
#pragma unroll
                for (int m = 0; m < 4; ++m) { float sacc = 0.f;
#pragma unroll
                    for (int bj = 0; bj < 2; ++bj)
#pragma unroll
                        for (int n = 0; n < 2; ++n) { const f32x4 t = acc[ai][bj][m][n] * rs[ai][m] + sw[bj][n]; v[ai][m][bj][n] = t; sacc += (t.x * t.x + t.y * t.y) + (t.z * t.z + t.w * t.w); }
                    sacc += __shfl_xor(sacc, 16); sacc += __shfl_xor(sacc, 32);
                    if (fq == 0) xch[wid8 * 128 + (ai * 4 + m) * 16 + fr] = sacc; }
            asm volatile("s_waitcnt lgkmcnt(0)" ::: "memory"); __builtin_amdgcn_s_barrier(); asm volatile("" ::: "memory");
            if (u.pn < 5) {
                const int hd = 2 * u.pn + (wc >> 1), dd = 32 * (wc & 1) + 8 * fq;
                const float* gg = (u.pn < 4 ? g1 : g2);
                f32x4 ga[2][2];
#pragma unroll
                for (int bj = 0; bj < 2; ++bj)
#pragma unroll
                    for (int n = 0; n < 2; ++n) ga[bj][n] = *(const f32x4*)(gg + bj * 64 + dd + 4 * n);
                const int tq = u.pm % 9; const bool lat = tq != 0;
#pragma unroll
                for (int ai = 0; ai < 2; ++ai)
#pragma unroll
                    for (int m = 0; m < 4; ++m) { const int slot = (ai * 4 + m) * 16 + fr, lrow = wr * 64 + fr + ai * HALF + m * 16;
                        const float tot = xch[wid8 * 128 + slot] + xch[(wid8 ^ 1) * 128 + slot];
                        const float rn = 1.0f / sqrtf(tot * (1.f / 128.f) + EPS);
                        bf16_t* rowp = O + (size_t)(u.pm * BM + lrow) * 1536 + hd * 128 + dd;
                        f32x4 o1[2], o2[2];
#pragma unroll
                        for (int n = 0; n < 2; ++n) { const f32x4 y1 = v[ai][m][0][n] * rn * ga[0][n], y2 = v[ai][m][1][n] * rn * ga[1][n];
                            if (lat) { const int pos = (tq - 1) * 256 + lrow; const f32x4 cv = *(const f32x4*)(cosT + pos * 64 + dd + 4 * n), sv = *(const f32x4*)(sinT + pos * 64 + dd + 4 * n);
                                o1[n] = y1 * cv - y2 * sv; o2[n] = y1 * sv + y2 * cv; }
                            else { o1[n] = y1; o2[n] = y2; } }
                        u32x4 w; w.x = cvt_pk_bf16(o1[0][0], o1[0][1]); w.y = cvt_pk_bf16(o1[0][2], o1[0][3]); w.z = cvt_pk_bf16(o1[1][0], o1[1][1]); w.w = cvt_pk_bf16(o1[1][2], o1[1][3]);
                        *(u32x4*)rowp = w;
                        w.x = cvt_pk_bf16(o2[0][0], o2[0][1]); w.y = cvt_pk_bf16(o2[0][2], o2[0][3]); w.z = cvt_pk_bf16(o2[1][0], o2[1][1]); w.w = cvt_pk_bf16(o2[1][2], o2[1][3]);
                        *(u32x4*)(rowp + 64) = w; }
            } else {
                const int col0 = u.pn * BM + wc * 32 + 8 * fq;
#pragma unroll
                for (int ai = 0; ai < 2; ++ai)
#pragma unroll
                    for (int m = 0; m < 4; ++m) { bf16_t* rowp = O + (size_t)(row0 + ai * HALF + m * 16) * 1536 + col0;
#pragma unroll
                        for (int bj = 0; bj < 2; ++bj) { const f32x4 v0 = v[ai][m][bj][0], v1 = v[ai][m][bj][1];
                            u32x4 w; w.x = cvt_pk_bf16(v0[0], v0[1]); w.y = cvt_pk_bf16(v0[2], v0[3]); w.z = cvt_pk_bf16(v1[0], v1[1]); w.w = cvt_pk_bf16(v1[2], v1[3]);
                            *(u32x4*)(rowp + bj * HALF) = w; } }
            }
            asm volatile("s_waitcnt lgkmcnt(0)" ::: "memory"); __builtin_amdgcn_s_barrier(); asm volatile("" ::: "memory");
        } else if constexpr (KIND == EK_MLAD) {
            float rs[2][4]; f32x4 sw[2][2]; coefs(mi_, row0, u.pn * BM + wc * 32 + 8 * fq, 4, rs, sw);
            if (u.pn < 4) {
                const bool isq = u.pn < 3;
                bf16_t* base = isq ? O : O2; const int ld = isq ? 768 : 256; const int cbase = (isq ? u.pn * BM : 0) + wc * 32 + 8 * fq;
                const float* gg = (isq ? g1 : g2) + cbase; u64* ssp = isq ? ssa : ssb;
                f32x4 gvv[2][2];
#pragma unroll
                for (int bj = 0; bj < 2; ++bj)
#pragma unroll
                    for (int n = 0; n < 2; ++n) gvv[bj][n] = *(const f32x4*)(gg + bj * HALF + 4 * n);
#pragma unroll
                for (int ai = 0; ai < 2; ++ai)
#pragma unroll
                    for (int m = 0; m < 4; ++m) { const int row = row0 + ai * HALF + m * 16; float sacc = 0.f;
#pragma unroll
                        for (int bj = 0; bj < 2; ++bj) { const f32x4 v0 = acc[ai][bj][m][0] * rs[ai][m] + sw[bj][0], v1 = acc[ai][bj][m][1] * rs[ai][m] + sw[bj][1];
                            sacc += ((v0.x * v0.x + v0.y * v0.y) + (v0.z * v0.z + v0.w * v0.w)) + ((v1.x * v1.x + v1.y * v1.y) + (v1.z * v1.z + v1.w * v1.w));
                            const f32x4 o0 = v0 * gvv[bj][0], o1 = v1 * gvv[bj][1];
                            u32x4 w; w.x = cvt_pk_bf16(o0[0], o0[1]); w.y = cvt_pk_bf16(o0[2], o0[3]); w.z = cvt_pk_bf16(o1[0], o1[1]); w.w = cvt_pk_bf16(o1[2], o1[3]);
                            *(u32x4*)(base + (size_t)row * ld + cbase + bj * HALF) = w; }
                        sacc += __shfl_xor(sacc, 16); sacc += __shfl_xor(sacc, 32);
                        if (fq == 0) atomicAdd(ssp + row, SSQ_FIX(sacc)); }
            } else if (wc == 0) {
                const int tq = u.pm % 9; const bool lat = tq != 0;
#pragma unroll
                for (int ai = 0; ai < 2; ++ai)
#pragma unroll
                    for (int m = 0; m < 4; ++m) { const int lrow = wr * 64 + fr + ai * HALF + m * 16;
                        bf16_t* rowp = O3 + (size_t)(u.pm * BM + lrow) * 64 + 8 * fq;
                        f32x4 o1[2], o2[2];
#pragma unroll
                        for (int n = 0; n < 2; ++n) { const f32x4 x1 = acc[ai][0][m][n] * rs[ai][m] + sw[0][n], x2 = acc[ai][1][m][n] * rs[ai][m] + sw[1][n];
                            if (lat) { const int pos = (tq - 1) * 256 + lrow; const f32x4 cv = *(const f32x4*)(cosT + pos * 32 + 8 * fq + 4 * n), sv = *(const f32x4*)(sinT + pos * 32 + 8 * fq + 4 * n);
                                o1[n] = x1 * cv - x2 * sv; o2[n] = x1 * sv + x2 * cv; }
                            else { o1[n] = x1; o2[n] = x2; } }
                        u32x4 w; w.x = cvt_pk_bf16(o1[0][0], o1[0][1]); w.y = cvt_pk_bf16(o1[0][2], o1[0][3]); w.z = cvt_pk_bf16(o1[1][0], o1[1][1]); w.w = cvt_pk_bf16(o1[1][2], o1[1][3]);
                        *(u32x4*)rowp = w;
                        w.x = cvt_pk_bf16(o2[0][0], o2[0][1]); w.y = cvt_pk_bf16(o2[0][2], o2[0][3]); w.z = cvt_pk_bf16(o2[1][0], o2[1][1]); w.w = cvt_pk_bf16(o2[1][2], o2[1][3]);
                        *(u32x4*)(rowp + 32) = w; }
            }
        } else {
            float rs[2][4]; f32x4 sw[2][2]; coefs(mi_, row0, 0, 4, rs, sw);
            if (u.pn < 4) {
#pragma unroll
                for (int ai = 0; ai < 2; ++ai)
#pragma unroll
                    for (int m = 0; m < 4; ++m) { bf16_t* rowp = O + (size_t)(row0 + ai * HALF + m * 16) * 1536 + wc * 32 + 8 * fq;
#pragma unroll
                        for (int bj = 0; bj < 2; ++bj) { const f32x4 v0 = acc[ai][bj][m][0] * rs[ai][m], v1 = acc[ai][bj][m][1] * rs[ai][m];
                            u32x4 w; w.x = cvt_pk_bf16(v0[0], v0[1]); w.y = cvt_pk_bf16(v0[2], v0[3]); w.z = cvt_pk_bf16(v1[0], v1[1]); w.w = cvt_pk_bf16(v1[2], v1[3]);
                            *(u32x4*)(rowp + (2 * u.pn + bj) * 192) = w; } }
            } else {
                const int head = 4 * (u.pn - 4) + wc, j0 = 8 * fq;
                const int tq = u.pm % 9; const bool lat = tq != 0;
#pragma unroll
                for (int ai = 0; ai < 2; ++ai)
#pragma unroll
                    for (int m = 0; m < 4; ++m) { const int lrow = wr * 64 + fr + ai * HALF + m * 16;
                        bf16_t* rowp = O + (size_t)(u.pm * BM + lrow) * 1536 + head * 192 + 128 + j0;
                        f32x4 o1[2], o2[2];
                        if (lat) { const int pos = (tq - 1) * 256 + lrow;
#pragma unroll
                            for (int n = 0; n < 2; ++n) { const f32x4 cv = *(const f32x4*)(cosT + pos * 32 + j0 + 4 * n), sv = *(const f32x4*)(sinT + pos * 32 + j0 + 4 * n);
                                const f32x4 x1 = acc[ai][0][m][n] * rs[ai][m], x2 = acc[ai][1][m][n] * rs[ai][m]; o1[n] = x1 * cv - x2 * sv; o2[n] = x1 * sv + x2 * cv; }
                        } else { o1[0] = acc[ai][0][m][0] * rs[ai][m]; o1[1] = acc[ai][0][m][1] * rs[ai][m]; o2[0] = acc[ai][1][m][0] * rs[ai][m]; o2[1] = acc[ai][1][m][1] * rs[ai][m]; }
                        u32x4 w; w.x = cvt_pk_bf16(o1[0][0], o1[0][1]); w.y = cvt_pk_bf16(o1[0][2], o1[0][3]); w.z = cvt_pk_bf16(o1[1][0], o1[1][1]); w.w = cvt_pk_bf16(o1[1][2], o1[1][3]);
                        *(u32x4*)rowp = w;
                        w.x = cvt_pk_bf16(o2[0][0], o2[0][1]); w.y = cvt_pk_bf16(o2[0][2], o2[0][3]); w.z = cvt_pk_bf16(o2[1][0], o2[1][1]); w.w = cvt_pk_bf16(o2[1][2], o2[1][3]);
                        *(u32x4*)(rowp + 32) = w; }
            }
        }
    }
};
}

namespace att {
constexpr int NW = 8, QBLK = 32, KVBLK = 64;
constexpr float THR = 8.f;
constexpr int SHM_V = KVBLK * 128 * 2;
#define SBAR() __builtin_amdgcn_sched_barrier(0)
DI int crow(int r, int hi) { return (r & 3) + 8 * (r >> 2) + 4 * hi; }
DI unsigned cvtpk(float lo, float hi) { unsigned r; asm volatile("v_cvt_pk_bf16_f32 %0, %1, %2" : "=v"(r) : "v"(lo), "v"(hi)); return r; }
DI bf16x8 ld8(const bf16_t* p) { return *reinterpret_cast<const bf16x8*>(p); }

template <int DQK> struct Sc { static constexpr float SCALE = DQK == 128 ? 0.088388347648318440f : 0.072168783648703220f; };

template <int DQK>
DI void partialSM(f32x16& p0, f32x16& p1, float& m_reg, float& mn, float& alpha) {
  constexpr float SCALE = Sc<DQK>::SCALE;
  constexpr float C = SCALE * 1.4426950408889634f;
  float pmax = p0[0];
#pragma unroll
  for (int r = 1; r < 16; ++r) pmax = fmaxf(pmax, p0[r]);
#pragma unroll
  for (int r = 0; r < 16; ++r) pmax = fmaxf(pmax, p1[r]);
  { auto rr = __builtin_amdgcn_permlane32_swap(__float_as_uint(pmax), __float_as_uint(pmax), false, false);
    pmax = fmaxf(__uint_as_float(rr[0]), __uint_as_float(rr[1])); }
  if (__builtin_expect(__all(pmax - m_reg <= THR / SCALE), 1)) { mn = m_reg; alpha = 1.f; }
  else { mn = fmaxf(m_reg, pmax); alpha = __builtin_amdgcn_exp2f((m_reg - mn) * C); m_reg = mn; }
  float mnC = -mn * C;
#pragma unroll
  for (int r = 0; r < 16; ++r) p0[r] = fmaf(p0[r], C, mnC);
#pragma unroll
  for (int r = 0; r < 16; ++r) p1[r] = fmaf(p1[r], C, mnC);
#pragma unroll
  for (int r = 0; r < 16; ++r) p0[r] = __builtin_amdgcn_exp2f(p0[r]);
}
DI void finishSM(f32x16& p0, f32x16& p1, float alpha, float& l_reg, bf16x8& pa0, bf16x8& pa1, bf16x8& pa2, bf16x8& pa3) {
#pragma unroll
  for (int r = 0; r < 16; ++r) p1[r] = __builtin_amdgcn_exp2f(p1[r]);
  float ps = 0;
#pragma unroll
  for (int r = 0; r < 16; ++r) ps += p0[r];
#pragma unroll
  for (int r = 0; r < 16; ++r) ps += p1[r];
  { auto rr = __builtin_amdgcn_permlane32_swap(__float_as_uint(ps), __float_as_uint(ps), false, false);
    ps = __uint_as_float(rr[0]) + __uint_as_float(rr[1]); }
  l_reg = l_reg * alpha + ps;
#define PK4(P, BASE, OUT) do { unsigned a0 = cvtpk(P[BASE + 0], P[BASE + 1]), a1 = cvtpk(P[BASE + 2], P[BASE + 3]);   \
    unsigned b0 = cvtpk(P[BASE + 4], P[BASE + 5]), b1 = cvtpk(P[BASE + 6], P[BASE + 7]);                              \
    auto r0 = __builtin_amdgcn_permlane32_swap(a0, b0, false, false); auto r1 = __builtin_amdgcn_permlane32_swap(a1, b1, false, false); \
    u32x4 w = {r0[0], r1[0], r0[1], r1[1]}; OUT = *reinterpret_cast<bf16x8*>(&w); } while (0)
  PK4(p0, 0, pa0); PK4(p0, 8, pa1); PK4(p1, 0, pa2); PK4(p1, 8, pa3);
#undef PK4
}
#define KSWZ2(row, colB, RB) ((row) * (RB) + ((colB) ^ (((row) & 7) << 4)))
template <int DQK>
DI void qkt(f32x16& p0, f32x16& p1, const char* Ks, const bf16x8* qr, const char* qx, int r32, int hi) {
  constexpr int RB = DQK * 2;
  p0 = f32x16{}; p1 = f32x16{};
#pragma unroll
  for (int d0 = 0; d0 < DQK / 16; ++d0) { int cb = (d0 * 16 + hi * 8) * 2;
    bf16x8 b0 = *reinterpret_cast<const bf16x8*>(Ks + KSWZ2(r32, cb, RB));
    bf16x8 b1 = *reinterpret_cast<const bf16x8*>(Ks + KSWZ2(32 + r32, cb, RB));
    bf16x8 qf; if (d0 < 8) qf = qr[d0 < 8 ? d0 : 0]; else qf = *reinterpret_cast<const bf16x8*>(qx + (d0 - 8) * 1024);
    p0 = __builtin_amdgcn_mfma_f32_32x32x16_bf16(b0, qf, p0, 0, 0, 0);
    p1 = __builtin_amdgcn_mfma_f32_32x32x16_bf16(b1, qf, p1, 0, 0, 0); }
}
DI int v_st(int k, int c) { const int kk = (k & ~0xC) | ((k & 4) << 1) | ((k & 8) >> 1); return ((kk >> 3) * 4 + (c >> 5)) * 512 + ((kk & 7) * 32 + (c & 31)) * 2; }
DI int v_rd_base(int lane) { return ((lane & 3) << 3) | (((lane >> 2) & 3) << 6) | (((lane >> 4) & 1) << 5) | (((lane >> 5) & 1) << 8); }
constexpr int v_rd_off(int d0, int ks, int half) { return d0 * 512 + ks * 4096 + half * 2048; }
template <int OFF> DI s16x4 tr_read(int vb) {
  s16x4 r; asm volatile("ds_read_b64_tr_b16 %0, %1 offset:%2" : "=&v"(r) : "v"(vb), "i"(OFF) : "memory"); return r;
}
template <int D0> DI void pv_one(f32x16& od, int vb, bf16x8 pa0, bf16x8 pa1, bf16x8 pa2, bf16x8 pa3) {
  const s16x4 l0 = tr_read<v_rd_off(D0, 0, 0)>(vb), h0 = tr_read<v_rd_off(D0, 0, 1)>(vb), l1 = tr_read<v_rd_off(D0, 1, 0)>(vb), h1 = tr_read<v_rd_off(D0, 1, 1)>(vb);
  const s16x4 l2 = tr_read<v_rd_off(D0, 2, 0)>(vb), h2 = tr_read<v_rd_off(D0, 2, 1)>(vb), l3 = tr_read<v_rd_off(D0, 3, 0)>(vb), h3 = tr_read<v_rd_off(D0, 3, 1)>(vb);
  asm volatile("s_waitcnt lgkmcnt(0)" ::: "memory"); SBAR();
#define PK(L, H) (bf16x8){L[0], L[1], L[2], L[3], H[0], H[1], H[2], H[3]}
  od = __builtin_amdgcn_mfma_f32_32x32x16_bf16(pa0, PK(l0, h0), od, 0, 0, 0);
  od = __builtin_amdgcn_mfma_f32_32x32x16_bf16(pa1, PK(l1, h1), od, 0, 0, 0);
  od = __builtin_amdgcn_mfma_f32_32x32x16_bf16(pa2, PK(l2, h2), od, 0, 0, 0);
  od = __builtin_amdgcn_mfma_f32_32x32x16_bf16(pa3, PK(l3, h3), od, 0, 0, 0);
#undef PK
}
DI void pv_d0(f32x16* o, int vb, bf16x8 pa0, bf16x8 pa1, bf16x8 pa2, bf16x8 pa3) {
  pv_one<0>(o[0], vb, pa0, pa1, pa2, pa3); pv_one<1>(o[1], vb, pa0, pa1, pa2, pa3); pv_one<2>(o[2], vb, pa0, pa1, pa2, pa3); pv_one<3>(o[3], vb, pa0, pa1, pa2, pa3);
}

template <int DQK, int LDQ, int LDK, int SDEPTH>
DI void attn_body(const bf16_t* Qb, const bf16_t* Kh, const bf16_t* Vh, const bf16_t* Ph, bf16_t* Ob, int seq, char* lds) {
  constexpr int ND = DQK / 16, KRB = DQK * 2, SHM_K = KVBLK * KRB, LDO = 1024;
  const int tid = otid(), wid = tid >> 6, lane = tid & 63, r32 = lane & 31, hi = lane >> 5;
  char* V_lds = lds; char* K_lds = lds + 2 * SHM_V;
  float* ws = (float*)(lds + 2 * SHM_V + 2 * SHM_K) + wid * 64; float* li_l = ws; float* al_l = ws + 32;
  float m_reg = -1e30f, l_reg = 0; f32x16 o[4] = {}; bf16x8 qr[8];
  const bf16_t* Qw = Qb + (long)(wid * QBLK + r32) * LDQ + hi * 8;
#pragma unroll
  for (int d0 = 0; d0 < 8; ++d0) qr[d0] = ld8(Qw + d0 * 16);
  char* qx = lds + 2 * SHM_V + 2 * SHM_K + NW * 256 + wid * 4096 + lane * 16;
  if constexpr (DQK == 192) {
#pragma unroll
    for (int d0 = 8; d0 < ND; ++d0) *reinterpret_cast<bf16x8*>(qx + (d0 - 8) * 1024) = ld8(Qw + d0 * 16);
    asm volatile("s_waitcnt lgkmcnt(0)" ::: "memory");
  }
  const int sr = tid >> 4, sc = (tid & 15) * 8, vst0 = v_st(sr, sc), vst1 = v_st(32 + sr, sc);
  const int pr = tid >> 3, pc = (tid & 7) * 8;
  const int vb0 = (int)(uintptr_t)V_lds + v_rd_base(lane);
  struct { bf16x8 vs0, vs1, ks0, ks1, ps; } sr_[SDEPTH];
#define SLOAD(i, k0) do { sr_[i].vs0 = ld8(&Vh[(long)((k0) + sr) * LDK + sc]); sr_[i].vs1 = ld8(&Vh[(long)((k0) + 32 + sr) * LDK + sc]); \
    sr_[i].ks0 = ld8(&Kh[(long)((k0) + sr) * LDK + sc]); sr_[i].ks1 = ld8(&Kh[(long)((k0) + 32 + sr) * LDK + sc]);                       \
    if constexpr (DQK == 192) sr_[i].ps = ld8(&Ph[(long)((k0) + pr) * 64 + pc]); } while (0)
#define SWRITE(b, i) do { *(bf16x8*)(V_lds + (b) * SHM_V + vst0) = sr_[i].vs0;          \
    *(bf16x8*)(V_lds + (b) * SHM_V + vst1) = sr_[i].vs1; int kc = sc * 2;               \
    *(bf16x8*)(K_lds + (b) * SHM_K + KSWZ2(sr, kc, KRB)) = sr_[i].ks0;                  \
    *(bf16x8*)(K_lds + (b) * SHM_K + KSWZ2(32 + sr, kc, KRB)) = sr_[i].ks1;             \
    if constexpr (DQK == 192) *(bf16x8*)(K_lds + (b) * SHM_K + KSWZ2(pr, 256 + pc * 2, KRB)) = sr_[i].ps; } while (0)
#define SWAIT() do { if constexpr (SDEPTH == 2) { if constexpr (DQK == 192) asm volatile("s_waitcnt vmcnt(5)" ::: "memory"); else asm volatile("s_waitcnt vmcnt(4)" ::: "memory"); } \
    else asm volatile("s_waitcnt vmcnt(0)" ::: "memory"); } while (0)
#define RESC(a) do { if (__any((a) < 1.f)) { if (hi == 0) al_l[r32] = (a); asm volatile("s_waitcnt lgkmcnt(0)" ::: "memory"); \
    _Pragma("unroll") for (int d = 0; d < 4; ++d) _Pragma("unroll") for (int r = 0; r < 16; ++r) o[d][r] *= al_l[crow(r, hi)]; } } while (0)
  f32x16 pA0, pA1, pB0, pB1; float mnA, mnB, alA, alB; bf16x8 pa0, pa1, pa2, pa3; const int NT = seq / KVBLK;
  constexpr int SE = 0, SO = SDEPTH - 1;
  SLOAD(SE, 0); asm volatile("s_waitcnt vmcnt(0)" ::: "memory"); SWRITE(0, SE); __syncthreads();
  qkt<DQK>(pA0, pA1, K_lds, qr, qx, r32, hi); partialSM<DQK>(pA0, pA1, m_reg, mnA, alA);
  SLOAD(SO, KVBLK); if constexpr (SDEPTH == 2) { if (2 < NT) SLOAD(SE, 2 * KVBLK); }
  SWAIT(); SWRITE(1, SO); __syncthreads();
  for (int j = 1; j + 1 < NT; j += 2) {
    SBAR(); qkt<DQK>(pB0, pB1, K_lds + SHM_K, qr, qx, r32, hi);
    finishSM(pA0, pA1, alA, l_reg, pa0, pa1, pa2, pa3); SBAR();
    SLOAD(SO, (j + SDEPTH) * KVBLK); SBAR();
    pv_d0(o, vb0, pa0, pa1, pa2, pa3); partialSM<DQK>(pB0, pB1, m_reg, mnB, alB);
    __syncthreads(); SWAIT(); SWRITE(0, SE);
    RESC(alB); __syncthreads();
    SBAR(); qkt<DQK>(pA0, pA1, K_lds, qr, qx, r32, hi);
    finishSM(pB0, pB1, alB, l_reg, pa0, pa1, pa2, pa3); SBAR();
    if (SDEPTH == 1 || j + 3 < NT) SLOAD(SE, (j + 1 + SDEPTH) * KVBLK); SBAR();
    pv_d0(o, vb0 + (int)SHM_V, pa0, pa1, pa2, pa3); partialSM<DQK>(pA0, pA1, m_reg, mnA, alA);
    __syncthreads(); SWAIT(); SWRITE(1, SO);
    RESC(alA); __syncthreads();
  }
  SBAR(); qkt<DQK>(pB0, pB1, K_lds + SHM_K, qr, qx, r32, hi);
  finishSM(pA0, pA1, alA, l_reg, pa0, pa1, pa2, pa3); SBAR();
  pv_d0(o, vb0, pa0, pa1, pa2, pa3); partialSM<DQK>(pB0, pB1, m_reg, mnB, alB);
  __syncthreads(); RESC(alB);
  finishSM(pB0, pB1, alB, l_reg, pa0, pa1, pa2, pa3); SBAR();
  pv_d0(o, vb0 + (int)SHM_V, pa0, pa1, pa2, pa3);
  if (hi == 0) li_l[r32] = l_reg; asm volatile("s_waitcnt lgkmcnt(0)" ::: "memory");
  float rli[16];
#pragma unroll
  for (int r = 0; r < 16; ++r) rli[r] = __builtin_amdgcn_rcpf(li_l[crow(r, hi)]);
  bf16_t* Ow = Ob + (long)(wid * QBLK) * LDO;
#pragma unroll
  for (int r = 0; r < 16; ++r) { int orow = crow(r, hi);
#pragma unroll
    for (int d0 = 0; d0 < 4; ++d0) Ow[(long)orow * LDO + d0 * 32 + r32] = (bf16_t)f2bf(o[d0][r] * rli[r]); }
#undef SLOAD
#undef SWRITE
#undef SWAIT
#undef RESC
}
}

DI int wrow(int mode, int p0, int n) {
    if (mode == 0) return p0 + n;
    if (mode == 1) { if (n < 1024) return n; const int s = (n - 1024) >> 10, ch = (n - 1024) & 1023; return 1024 + ((ch >> 7) << 8) + (s << 7) + (ch & 127); }
    if (mode == 2) return ((n >> 7) << 8) + (p0 << 7) + (n & 127);
    if (mode == 5) { const int hd = n >> 7, d = n & 127; return p0 + ((hd >> 1) << 8) + ((d >> 6) << 7) + ((hd & 1) << 6) + (d & 63); }
    if (mode == 4) { if (n < 256) return 768 + n; const int j = n - 256; return 1024 + ((j >> 5) << 7) + (j & 31); }
    const int h = n / 192, d = n - h * 192;
    if (d < 128) return ((h >> 1) << 8) + ((h & 1) << 7) + d;
    const int j = d - 128; return 1024 + ((h >> 2) << 8) + ((j >> 5) << 7) + ((h & 3) << 5) + (j & 31);
}
DI void transpose_item(const float* W, int K, int N, bf16_t* WT, int mode, int p0, LAS float* scr, int item, int lane) {
    const int nblk = N / 32, kb = item / nblk, nb = item - kb * nblk, k0 = 64 * kb, n0 = 32 * nb;
#pragma unroll
    for (int i = 0; i < 32; ++i) { const int kk = 2 * i + (lane >> 5); scr[kk * 33 + (lane & 31)] = __builtin_nontemporal_load(W + (size_t)(k0 + kk) * N + n0 + (lane & 31)); }
    LDS_WAIT(); asm volatile("" ::: "memory");
    const int c = lane & 7;
#pragma unroll
    for (int j = 0; j < 4; ++j) { const int n = (lane >> 3) + 8 * j; const LAS float* s = scr + (8 * c) * 33 + n;
        u32x4 o; o.x = pk2(s[0 * 33], s[1 * 33]); o.y = pk2(s[2 * 33], s[3 * 33]); o.z = pk2(s[4 * 33], s[5 * 33]); o.w = pk2(s[6 * 33], s[7 * 33]);
        *(u32x4*)(WT + (size_t)wrow(mode, p0, n0 + n) * K + k0 + 8 * c) = o; }
    LDS_WAIT(); asm volatile("" ::: "memory");
}

DI void transposes_items(const Params& P, LAS unsigned char* lds, int first, int last, int slot, int nslots, int deferred, int lane) {
    unsigned char* ws = P.ws; const int wave = otid() >> 6;
    LAS float* scr = (LAS float*)(lds + 61440 + wave * 8448);
    constexpr int I_FF = 1408, I_L = 3 * I_FF, I_CI = 1536, I_CO = 512, I_CV = I_CI + I_CO;
    constexpr int N0 = 4 * I_L, N1 = N0 + 2 * I_CV, N2 = N1 + 512 + 128 + 128 + 512, N3 = N2 + 384 + 160 + 576 + 256 + 512;
    static_assert(N3 - N0 - I_CV + 3 * I_L == 17888 && I_L + I_CV == 6272, "item counts");
    for (int d = first + slot; d < last; d += nslots) {
        int it;
        if (!deferred) it = d < I_L ? d : N0 + (d - I_L);
        else it = d < 3 * I_L ? I_L + d : N0 + I_CV + (d - 3 * I_L);
        const float* W; int K, N, mode = 0, p0 = 0, item; bf16_t* WT;
        if (it < N0) { const int l = it / I_L, q = it - l * I_L, wh = q / I_FF; item = q - wh * I_FF;
            if (wh == 0) { W = P.in[8] + (size_t)l * DM * FF; K = DM; N = FF; WT = (bf16_t*)(ws + WS_WUP + l * SZ_WUP); mode = 2; p0 = 0; }
            else if (wh == 1) { W = P.in[9] + (size_t)l * DM * FF; K = DM; N = FF; WT = (bf16_t*)(ws + WS_WUP + l * SZ_WUP); mode = 2; p0 = 1; }
            else { W = P.in[10] + (size_t)l * FF * DM; K = FF; N = DM; WT = (bf16_t*)(ws + WS_WDN + l * SZ_WDN); } }
        else if (it < N1) { const int r = it - N0, j = r / I_CV, q = r - j * I_CV;
            if (q < I_CI) { item = q; W = P.in[11] + (size_t)j * DM * 3072; K = DM; N = 3072; WT = (bf16_t*)(ws + WS_WCI + j * SZ_WCI); mode = 1; }
            else { item = q - I_CI; W = P.in[13] + (size_t)j * DM * DM; K = DM; N = DM; WT = (bf16_t*)(ws + WS_WCO + j * SZ_WSQ); } }
        else if (it < N2) { int r = it - N1;
            if (r < 512) { item = r; W = P.in[14]; K = DM; N = DM; WT = (bf16_t*)(ws + WS_WQKV); mode = 5; p0 = 0; }
            else if (r < 640) { item = r - 512; W = P.in[15]; K = DM; N = 256; WT = (bf16_t*)(ws + WS_WQKV); mode = 5; p0 = 1024; }
            else if (r < 768) { item = r - 640; W = P.in[16]; K = DM; N = 256; WT = (bf16_t*)(ws + WS_WQKV); p0 = 1280; }
            else { item = r - 768; W = P.in[19]; K = DM; N = DM; WT = (bf16_t*)(ws + WS_WGO); } }
        else { int r = it - N2;
            if (r < 384) { item = r; W = P.in[20]; K = DM; N = 768; WT = (bf16_t*)(ws + WS_WD); p0 = 0; }
            else if (r < 544) { item = r - 384; W = P.in[23]; K = DM; N = 320; WT = (bf16_t*)(ws + WS_WD); mode = 4; }
            else if (r < 1120) { item = r - 544; W = P.in[22]; K = 768; N = 1536; WT = (bf16_t*)(ws + WS_WUQ); mode = 3; }
            else if (r < 1376) { item = r - 1120; W = P.in[25]; K = 256; N = 2048; WT = (bf16_t*)(ws + WS_WUKV); }
            else { item = r - 1376; W = P.in[26]; K = DM; N = DM; WT = (bf16_t*)(ws + WS_WMO); } }
        transpose_item(W, K, N, WT, mode, p0, scr, item, lane);
    }
}

DI void prologue_phase(const Params& P, LAS unsigned char* lds, int G) {
    const int tid = otid(), lane = tid & 63, wave = tid >> 6;
    unsigned char* ws = P.ws;
    {
        LAS float* sc = (LAS float*)lds; LAS float* red = sc + 9 * DM;
        for (int i = tid; i < 9 * DM; i += NTHREADS) { const int r = i >> 10, k = i & 1023; const float v = r < 8 ? P.in[1][r * DM + k] : P.in[3][k]; sc[i] = v / (1.f + __expf(-v)); }
        __syncthreads();
        float* MOD = (float*)(ws + WS_MOD);
        for (int item = blockIdx.x; item < 4 * 48; item += G) {
            const int l = item / 48, n0 = (item - l * 48) * 128, ks = tid >> 5, cq = tid & 31;
            const float* Wp = P.in[4] + ((size_t)l * DM + ks * 64) * NMOD + n0 + 4 * cq;
            f32x4 a[9];
#pragma unroll
            for (int r = 0; r < 9; ++r) a[r] = (f32x4){0.f, 0.f, 0.f, 0.f};
            const LAS float* s = sc + ks * 64;
#pragma unroll 2
            for (int k4 = 0; k4 < 64; k4 += 4) {
                f32x4 w[4];
#pragma unroll
                for (int q = 0; q < 4; ++q) w[q] = __builtin_nontemporal_load((const f32x4*)(Wp + (size_t)(k4 + q) * NMOD));
#pragma unroll
                for (int r = 0; r < 9; ++r) { const f32x4 sv = *(const LAS f32x4*)(s + r * DM + k4);
                    a[r] += w[0] * sv.x; a[r] += w[1] * sv.y; a[r] += w[2] * sv.z; a[r] += w[3] * sv.w; } }
#pragma unroll
            for (int r = 0; r < 9; ++r) *(LAS f32x4*)(red + (ks * 9 + r) * 128 + 4 * cq) = a[r];
            __syncthreads();
            for (int o = tid; o < 9 * 128; o += NTHREADS) { const int r = o >> 7, c2 = o & 127; float sum = 0.f;
#pragma unroll
                for (int q = 0; q < 16; ++q) sum += red[(q * 9 + r) * 128 + c2];
                MOD[((size_t)l * 9 + r) * NMOD + n0 + c2] = sum + P.in[5][l * NMOD + n0 + c2]; }
            __syncthreads();
        }
    }
    {
        float* gc = (float*)(ws + WS_RGC); float* gs = (float*)(ws + WS_RGS); float* mc = (float*)(ws + WS_RMC); float* ms = (float*)(ws + WS_RMS);
        const int gt = blockIdx.x * NTHREADS + tid, NT_ = G * NTHREADS;
        for (int i = gt; i < SEQ * 96; i += NT_) {
            const int pos = i / 96, a = i - pos * 96; const float row = (float)(pos >> 6), col = (float)(pos & 63);
            if (a < 64) { const int fi = a & 31; const float fr = powf(10000.f, -(float)fi / 32.f); const float ang = (a < 32 ? row : col) * fr;
                gc[pos * 64 + a] = cosf(ang); gs[pos * 64 + a] = sinf(ang); }
            else { const int a2 = a - 64, fi = a2 & 15; const float fr = powf(10000.f, -(float)fi / 16.f); const float ang = (a2 < 16 ? row : col) * fr;
                mc[pos * 32 + a2] = cosf(ang); ms[pos * 32 + a2] = sinf(ang); }
        }
        { u32x4* zs = (u32x4*)(ws + WS_SS); for (int i = gt; i < 10 * T / 2; i += NT_) zs[i] = (u32x4){0u, 0u, 0u, 0u}; }
        { u32x4* z1 = (u32x4*)(ws + WS_WD + (size_t)1056 * DM * 2); u32x4* z2 = (u32x4*)(ws + WS_WD + (size_t)1184 * DM * 2);
          for (int i = gt; i < 96 * DM * 2 / 16; i += NT_) { z1[i] = (u32x4){0u, 0u, 0u, 0u}; z2[i] = (u32x4){0u, 0u, 0u, 0u}; } }
    }
    transposes_items(P, lds, 0, 6272, blockIdx.x * NWAVES + wave, G * NWAVES, 0, lane);
    transposes_items(P, lds, 0, 17888, blockIdx.x * NWAVES + wave, G * NWAVES, 1, lane);
}

DI void prenorm_phase(const float* XL, const float* XC, const float* g, const float* scv, bf16_t* XS, u64* SS, bf16_t* XLb, bf16_t* XCb, int G) {
    const int tid = otid(), lane = tid & 63, gw = blockIdx.x * NWAVES + (tid >> 6), NGW = G * NWAVES;
    for (int r0 = gw; r0 < T; r0 += 3 * NGW) {
        const float* xr[3]; int mi[3], rr[3]; bool ok[3]; bf16_t* xb[3];
#pragma unroll
        for (int q = 0; q < 3; ++q) { const int r = r0 + q * NGW; ok[q] = r < T; rr[q] = ok[q] ? r : r0;
            const int b = rr[q] / RPB, w = rr[q] - b * RPB;
            if (w < CTXL) { xr[q] = XC + (size_t)(b * CTXL + w) * DM; xb[q] = XCb + (size_t)(b * CTXL + w) * DM; mi[q] = 8; } else { xr[q] = XL + (size_t)(b * SEQ + w - CTXL) * DM; xb[q] = XLb + (size_t)(b * SEQ + w - CTXL) * DM; mi[q] = b; } }
        f32x4 v[3][4]; float ss[3];
#pragma unroll
        for (int q = 0; q < 3; ++q)
#pragma unroll
            for (int j = 0; j < 4; ++j) v[q][j] = ((const f32x4*)xr[q])[lane + 64 * j];
#pragma unroll
        for (int q = 0; q < 3; ++q) { float a = 0.f;
#pragma unroll
            for (int j = 0; j < 4; ++j) a += (v[q][j].x * v[q][j].x + v[q][j].y * v[q][j].y) + (v[q][j].z * v[q][j].z + v[q][j].w * v[q][j].w);
            ss[q] = a; }
#pragma unroll
        for (int o = 1; o < 64; o <<= 1)
#pragma unroll
            for (int q = 0; q < 3; ++q) ss[q] += __shfl_xor(ss[q], o);
#pragma unroll
        for (int q = 0; q < 3; ++q) if (ok[q]) {
            if (lane == 0) SS[rr[q]] = SSQ_FIX(ss[q]);
#pragma unroll
            for (int j = 0; j < 4; ++j) { const int col = 4 * (lane + 64 * j);
                const f32x4 gv = *(const f32x4*)(g + col), sc = *(const f32x4*)(scv + (size_t)mi[q] * NMOD + col);
                const f32x4 o = v[q][j] * gv * (sc + 1.0f);
                u32x2 w2; w2.x = pk2(o.x, o.y); w2.y = pk2(o.z, o.w);
                *(u32x2*)(XS + (size_t)rr[q] * DM + col) = w2;
                u32x2 w3; w3.x = pk2(v[q][j].x, v[q][j].y); w3.y = pk2(v[q][j].z, v[q][j].w); *(u32x2*)(xb[q] + col) = w3; } }
    }
}
DI void ctxfix_phase(const bf16_t* XCsrc, bf16_t* XC, const float* slab, const float* gate, const float* g, const float* scv, bf16_t* XS, u64* SS, int G) {
    const int tid = otid(), lane = tid & 63, gw = blockIdx.x * NWAVES + (tid >> 6), NGW = G * NWAVES;
    for (int rc = gw; rc < NB * CTXL; rc += NGW) {
        const int b = rc >> 8, w = rc & 255, r = b * RPB + w; bf16_t* xr = XC + (size_t)rc * DM; const bf16_t* xs_ = XCsrc + (size_t)rc * DM;
        f32x4 v[4]; float ss = 0.f;
#pragma unroll
        for (int j = 0; j < 4; ++j) {
            const float* sp = slab + (size_t)((b * 4 + j) * 4) * 65536 + (size_t)w * 256 + 4 * lane;
            const f32x4 p0 = *(const f32x4*)sp, p1 = *(const f32x4*)(sp + 65536), p2 = *(const f32x4*)(sp + 2 * 65536), p3 = *(const f32x4*)(sp + 3 * 65536);
            const u32x2 tx = ((const u32x2*)xs_)[lane + 64 * j]; const f32x4 x0 = {bflo(tx.x), bfhi(tx.x), bflo(tx.y), bfhi(tx.y)}, gt4 = *(const f32x4*)(gate + (size_t)8 * NMOD + 4 * (lane + 64 * j));
            v[j] = x0 + gt4 * ((p0 + p1) + (p2 + p3));
            ss += (v[j].x * v[j].x + v[j].y * v[j].y) + (v[j].z * v[j].z + v[j].w * v[j].w); }
        ss = wave_sum(ss); if (lane == 0) SS[r] = SSQ_FIX(ss);
#pragma unroll
        for (int j = 0; j < 4; ++j) { const int col = 4 * (lane + 64 * j);
            { u32x2 wx; wx.x = pk2(v[j].x, v[j].y); wx.y = pk2(v[j].z, v[j].w); ((u32x2*)xr)[lane + 64 * j] = wx; }
            const f32x4 gv = *(const f32x4*)(g + col), sc = *(const f32x4*)(scv + (size_t)8 * NMOD + col);
            const f32x4 o = v[j] * gv * (sc + 1.0f);
            u32x2 w2; w2.x = pk2(o.x, o.y); w2.y = pk2(o.z, o.w);
            *(u32x2*)(XS + (size_t)r * DM + col) = w2; }
    }
}
DI void shw_phase(unsigned char* ws, LAS unsigned char* lds, int first, int stride, int set, int lo, int hi) {
    const int tid = otid(), lane = tid & 63, w = tid >> 6;
    const float* MOD = (const float*)(ws + WS_MOD);
    LAS float* shl = (LAS float*)lds; LAS float* red = shl + 9 * DM;
    int cur = -1;
    for (int it = lo + first; it < hi; it += stride) {
        const bf16_t* Wt; const float* sh; float* out; int N, c, cid;
        if (!set) {
            if (it < 48) { cid = 0; c = it; Wt = (const bf16_t*)(ws + WS_WCI); sh = MOD; out = (float*)(ws + WS_SHWI); N = 3072; }
            else { cid = 4; c = it - 48; Wt = (const bf16_t*)(ws + WS_WUP); sh = MOD + 3 * DM; out = (float*)(ws + WS_SHWU); N = 5632; }
        } else {
            if (it < 24) { cid = 1; c = it; Wt = (const bf16_t*)(ws + WS_WQKV); sh = MOD + (size_t)1 * 9 * NMOD; out = (float*)(ws + WS_SHWI) + 1 * 9 * 3072; N = 1536; }
            else if (it < 44) { cid = 2; c = it - 24; Wt = (const bf16_t*)(ws + WS_WD); sh = MOD + (size_t)2 * 9 * NMOD; out = (float*)(ws + WS_SHWI) + 2 * 9 * 3072; N = 1280; }
            else if (it < 92) { cid = 3; c = it - 44; Wt = (const bf16_t*)(ws + WS_WCI + SZ_WCI); sh = MOD + (size_t)3 * 9 * NMOD; out = (float*)(ws + WS_SHWI) + 3 * 9 * 3072; N = 3072; }
            else { const int q = it - 92, l = 1 + q / 88; cid = 4 + l; c = q - (l - 1) * 88; Wt = (const bf16_t*)(ws + WS_WUP + l * SZ_WUP); sh = MOD + (size_t)l * 9 * NMOD + 3 * DM; out = (float*)(ws + WS_SHWU) + (size_t)l * 9 * 5632; N = 5632; }
        }
        if (cid != cur) { __syncthreads(); for (int i = tid; i < 9 * DM; i += NTHREADS) shl[i] = sh[(size_t)(i >> 10) * NMOD + (i & 1023)]; cur = cid; __syncthreads(); }
        const u32x4* wp = (const u32x4*)(Wt + (size_t)(c * 64 + lane) * DM + 128 * w);
        float a[9];
#pragma unroll
        for (int mi = 0; mi < 9; ++mi) a[mi] = 0.f;
#pragma unroll 4
        for (int ch = 0; ch < 16; ++ch) { const u32x4 wv = wp[ch];
            const float e0 = bflo(wv.x), e1 = bfhi(wv.x), e2 = bflo(wv.y), e3 = bfhi(wv.y), e4 = bflo(wv.z), e5 = bfhi(wv.z), e6 = bflo(wv.w), e7 = bfhi(wv.w);
#pragma unroll
            for (int mi = 0; mi < 9; ++mi) { const LAS f32x4* sp = (const LAS f32x4*)(shl + mi * DM + 128 * w + 8 * ch); const f32x4 s0 = sp[0], s1 = sp[1];
                a[mi] += (s0.x * e0 + s0.y * e1) + (s0.z * e2 + s0.w * e3) + (s1.x * e4 + s1.y * e5) + (s1.z * e6 + s1.w * e7); } }
#pragma unroll
        for (int mi = 0; mi < 9; ++mi) red[(w * 9 + mi) * 64 + lane] = a[mi];
        __syncthreads();
        for (int o = tid; o < 9 * 64; o += NTHREADS) { const int mi = o >> 6, c2 = o & 63; float sum = 0.f;
#pragma unroll
            for (int q = 0; q < 8; ++q) sum += red[(q * 9 + mi) * 64 + c2];
            out[(size_t)mi * N + c * 64 + c2] = sum; }
        __syncthreads();
    }
}

DI void conv_phase(const bf16_t* __restrict__ BUF1, const float* __restrict__ cw, bf16_t* __restrict__ H, bool latonly, int G) {
    const int gt = blockIdx.x * NTHREADS + otid(), NT_ = G * NTHREADS;
    if ((NT_ & 127) == 0) {
        const int c8 = (gt & 127) * 8, rstep = NT_ >> 7;
        float w0[8], w1[8], w2[8];
#pragma unroll
        for (int q = 0; q < 8; ++q) { w0[q] = cw[c8 + q]; w1[q] = cw[DM + c8 + q]; w2[q] = cw[2 * DM + c8 + q]; }
#pragma unroll 3
        for (int r = gt >> 7; r < T; r += rstep) {
            const int b = r / RPB, w = r - b * RPB;
            if (latonly && w < CTXL) continue;
            const bool hp = !(w == 0 || w == CTXL), hn = !(w == CTXL - 1 || w == RPB - 1);
            const bf16_t* up = BUF1 + (size_t)r * 2048 + 1024 + c8;
            const u32x4 zero = {0u, 0u, 0u, 0u};
            const u32x4 uc = *(const u32x4*)up, um = hp ? *(const u32x4*)(up - 2048) : zero, un = hn ? *(const u32x4*)(up + 2048) : zero;
            const u32x4 bb = *(const u32x4*)(BUF1 + (size_t)r * 2048 + c8);
            u32x4 o;
#pragma unroll
            for (int q = 0; q < 4; ++q) {
                const float z0 = bflo(um[q]) * w0[2 * q] + bflo(uc[q]) * w1[2 * q] + bflo(un[q]) * w2[2 * q];
                const float z1 = bfhi(um[q]) * w0[2 * q + 1] + bfhi(uc[q]) * w1[2 * q + 1] + bfhi(un[q]) * w2[2 * q + 1];
                o[q] = pk2(bflo(bb[q]) * z0, bfhi(bb[q]) * z1);
            }
            *(u32x4*)(H + (size_t)r * DM + c8) = o;
        }
        return;
    }
    for (int idx = gt; idx < T * 128; idx += NT_) {
        const int r = idx >> 7, c8 = (idx & 127) * 8; const int b = r / RPB, w = r - b * RPB;
        if (latonly && w < CTXL) continue;
        const bool hp = !(w == 0 || w == CTXL), hn = !(w == CTXL - 1 || w == RPB - 1);
        const bf16_t* up = BUF1 + (size_t)r * 2048 + 1024 + c8;
        const u32x4 zero = {0u, 0u, 0u, 0u};
        const u32x4 uc = *(const u32x4*)up, um = hp ? *(const u32x4*)(up - 2048) : zero, un = hn ? *(const u32x4*)(up + 2048) : zero;
        const u32x4 bb = *(const u32x4*)(BUF1 + (size_t)r * 2048 + c8);
        u32x4 o;
#pragma unroll
        for (int q = 0; q < 4; ++q) {
            const int ch = c8 + 2 * q;
            const float z0 = bflo(um[q]) * cw[ch] + bflo(uc[q]) * cw[DM + ch] + bflo(un[q]) * cw[2 * DM + ch];
            const float z1 = bfhi(um[q]) * cw[ch + 1] + bfhi(uc[q]) * cw[DM + ch + 1] + bfhi(un[q]) * cw[2 * DM + ch + 1];
            o[q] = pk2(bflo(bb[q]) * z0, bfhi(bb[q]) * z1);
        }
        *(u32x4*)(H + (size_t)r * DM + c8) = o;
    }
}

DI void gqa_qknorm_phase(bf16_t* QKV, const float* qg, const float* kg, const float* cosT, const float* sinT, int G) {
    const int tid = otid(), lane = tid & 63, gw = blockIdx.x * NWAVES + (tid >> 6), NGW = G * NWAVES;
    for (int r = gw; r < T; r += NGW) {
        const int b = r / RPB, w = r - b * RPB; const bool lat = w >= CTXL; const int pos = w - CTXL;
        const float c = lat ? cosT[pos * 64 + lane] : 1.f, s = lat ? sinT[pos * 64 + lane] : 0.f;
        bf16_t* p = QKV + (size_t)r * 1536;
        float x1[10], x2[10], sq[10];
#pragma unroll
        for (int hh = 0; hh < 10; ++hh) { x1[hh] = bf2f(p[hh * 128 + lane]); x2[hh] = bf2f(p[hh * 128 + 64 + lane]); }
#pragma unroll
        for (int hh = 0; hh < 10; ++hh) sq[hh] = x1[hh] * x1[hh] + x2[hh] * x2[hh];
#pragma unroll
        for (int o = 1; o < 64; o <<= 1)
#pragma unroll
            for (int hh = 0; hh < 10; ++hh) sq[hh] += __shfl_xor(sq[hh], o);
        const float qg1 = qg[lane], qg2 = qg[64 + lane], kg1 = kg[lane], kg2 = kg[64 + lane];
#pragma unroll
        for (int hh = 0; hh < 10; ++hh) {
            const float rstd = 1.0f / sqrtf(sq[hh] * (1.f / 128.f) + EPS);
            const float y1 = x1[hh] * rstd * (hh < 8 ? qg1 : kg1), y2 = x2[hh] * rstd * (hh < 8 ? qg2 : kg2);
            p[hh * 128 + lane] = (bf16_t)f2bf(y1 * c - y2 * s); p[hh * 128 + 64 + lane] = (bf16_t)f2bf(y1 * s + y2 * c);
        }
    }
}

DI void mla_norm_phase(const float* C1, const float* qg, const float* kvg, const float* cosT, const float* sinT, bf16_t* CQ, bf16_t* CKV, bf16_t* KPE, int G) {
    const int tid = otid(), lane = tid & 63, gw = blockIdx.x * NWAVES + (tid >> 6), NGW = G * NWAVES;
    for (int r = gw; r < T; r += NGW) {
        const int b = r / RPB, w = r - b * RPB; const bool lat = w >= CTXL; const int pos = w - CTXL;
        const float* cr = C1 + (size_t)r * 1280;
        f32x4 v[3]; float ss = 0.f;
#pragma unroll
        for (int j = 0; j < 3; ++j) { v[j] = ((const f32x4*)cr)[lane + 64 * j]; ss += (v[j].x * v[j].x + v[j].y * v[j].y) + (v[j].z * v[j].z + v[j].w * v[j].w); }
        const float rq = 1.0f / sqrtf(wave_sum(ss) * (1.f / 768.f) + EPS);
#pragma unroll
        for (int j = 0; j < 3; ++j) { const int col = 4 * (lane + 64 * j); const f32x4 gv = *(const f32x4*)(qg + col); const f32x4 o = v[j] * rq * gv;
            u32x2 w2; w2.x = pk2(o.x, o.y); w2.y = pk2(o.z, o.w); *(u32x2*)(CQ + (size_t)r * 768 + col) = w2; }
        const f32x4 kv = ((const f32x4*)(cr + 768))[lane];
        const float rk = 1.0f / sqrtf(wave_sum((kv.x * kv.x + kv.y * kv.y) + (kv.z * kv.z + kv.w * kv.w)) * (1.f / 256.f) + EPS);
        { const f32x4 gv = *(const f32x4*)(kvg + 4 * lane); const f32x4 o = kv * rk * gv;
          u32x2 w2; w2.x = pk2(o.x, o.y); w2.y = pk2(o.z, o.w); *(u32x2*)(CKV + (size_t)r * 256 + 4 * lane) = w2; }
        if (lane < 32) { const float x1 = cr[1024 + lane], x2 = cr[1056 + lane];
            const float c = lat ? cosT[pos * 32 + lane] : 1.f, s = lat ? sinT[pos * 32 + lane] : 0.f;
            KPE[(size_t)r * 64 + lane] = (bf16_t)f2bf(x1 * c - x2 * s); KPE[(size_t)r * 64 + 32 + lane] = (bf16_t)f2bf(x1 * s + x2 * c); }
    }
}

template <int DQK, int LDQ, int LDK, int SDEPTH>
DI void attn_phase(const bf16_t* Q, int qhs, const bf16_t* Kb, const bf16_t* Vb, int khs, int kdiv, const bf16_t* KPE, bf16_t* O, char* lds, int G, int nunits) {
    for (int u = blockIdx.x; u < nunits; u += G) {
        int b, h, qrow, nk;
        if (u < 512) { h = u & 7; const int qb = (u >> 3) & 7; b = u >> 6; qrow = b * RPB + CTXL + qb * 256; nk = RPB; }
        else { const int uc = u - 512; h = uc & 7; b = uc >> 3; qrow = b * RPB; nk = CTXL; }
        const int kvh = h / kdiv; const size_t krow = (size_t)b * RPB;
        att::attn_body<DQK, LDQ, LDK, SDEPTH>(Q + (size_t)qrow * LDQ + h * qhs, Kb + krow * LDK + kvh * khs, Vb + krow * LDK + kvh * khs, KPE + krow * 64,
                                               O + (size_t)qrow * DM + h * 128, nk, lds);
        __syncthreads();
    }
}

#define XB_TMO      128
#define XB_XCNT(j)  (256  + 64 * (j))
#define XB_XSUB(j)  (1280 + 64 * (j))
#define XB_XGEN(j)  (2304 + 64 * (j))
#define XB_TOP      3328
#define XB_TOPGEN   3392
#define XCD_BAR_WORDS 3456
#define XB_SPIN_CAP (1u << 20)
DI unsigned xb_ld(unsigned* p)              { return __hip_atomic_load(p, __ATOMIC_RELAXED, __HIP_MEMORY_SCOPE_AGENT); }
DI unsigned xb_add(unsigned* p, unsigned v) { return __hip_atomic_fetch_add(p, v, __ATOMIC_RELAXED, __HIP_MEMORY_SCOPE_AGENT); }
DI unsigned xb_xcc_id() { return (unsigned)__builtin_amdgcn_s_getreg((3 << 11) | 20) & 0xFu; }
#define XB_SPIN(cond, bar) do { unsigned _sp = 0; while (cond) { __builtin_amdgcn_s_sleep(1); \
    if ((++_sp & 255u) == 0u) { if (xb_ld(&(bar)[XB_TMO])) break; if (_sp > XB_SPIN_CAP) { atomicAdd(&(bar)[XB_TMO], 1u); break; } } } } while (0)
struct XcdBarrier { unsigned* bar; unsigned x; volatile LAS unsigned* st; };
DI XcdBarrier xcd_barrier_post(unsigned* bar, volatile LAS unsigned* st) {
    XcdBarrier b; b.bar = bar; b.x = 0u; b.st = st;
    if (threadIdx.x == 0) { const unsigned x = xb_xcc_id(); st[2] = x; (void)xb_add(&bar[XB_XCNT(x)], 1u); }
    return b;
}
DI void xcd_barrier_complete(unsigned* bar, unsigned x, unsigned& nloc, unsigned& nx) {
    const unsigned G = gridDim.x * gridDim.y * gridDim.z;
    unsigned sum, cnt, mine, sp = 0u;
    for (;;) {
        sum = 0u; cnt = 0u; mine = 0u;
#pragma unroll
        for (unsigned j = 0; j < 16; ++j) { const unsigned c = xb_ld(&bar[XB_XCNT(j)]); sum += c; cnt += (c > 0u) ? 1u : 0u; mine = (j == x) ? c : mine; }
        if (sum == G) break;
        __builtin_amdgcn_s_sleep(1);
        if ((++sp & 255u) == 0u) { if (xb_ld(&bar[XB_TMO])) break; if (sp > XB_SPIN_CAP) { atomicAdd(&bar[XB_TMO], 1u); break; } }
    }
    nloc = mine > 0u ? mine : 1u; nx = cnt > 0u ? cnt : 1u;
}
DI void xcd_barrier(const XcdBarrier& b) {
    asm volatile("s_waitcnt vmcnt(0)" ::: "memory");
    __syncthreads();
    if (threadIdx.x == 0) {
        unsigned* bar = b.bar; asm volatile("" : "+s"(bar));
        __builtin_amdgcn_s_waitcnt(0);
        unsigned nloc = b.st[0], nx = b.st[1]; const unsigned bx = b.st[2];
        if (nloc == 0u) { xcd_barrier_complete(bar, bx, nloc, nx); b.st[0] = nloc; b.st[1] = nx; }
        const unsigned old = xb_add(&bar[XB_XSUB(bx)], 1u);
        const unsigned gen = old / nloc;
        if (old + 1u == (gen + 1u) * nloc) {
            __builtin_amdgcn_fence(__ATOMIC_RELEASE, "agent");
            asm volatile("s_waitcnt vmcnt(0)" ::: "memory");
            const unsigned og = xb_add(&bar[XB_TOP], 1u);
            const unsigned tg = og / nx;
            if (og + 1u == (tg + 1u) * nx) xb_add(&bar[XB_TOPGEN], 1u);
            else XB_SPIN(xb_ld(&bar[XB_TOPGEN]) == tg, bar);
            __builtin_amdgcn_fence(__ATOMIC_ACQUIRE, "agent");
            xb_add(&bar[XB_XGEN(bx)], 1u);
            asm volatile("s_waitcnt vmcnt(0)" ::: "memory");
        } else {
            XB_SPIN(xb_ld(&bar[XB_XGEN(bx)]) == gen, bar);
            __builtin_amdgcn_fence(__ATOMIC_ACQUIRE, "agent");
            asm volatile("s_waitcnt vmcnt(0)" ::: "memory");
        }
    }
    __syncthreads();
}

__global__ void __launch_bounds__(NTHREADS, 2) fwd_megakernel(Params P) {
    extern __shared__ __attribute__((aligned(16))) unsigned char lds_raw[];
    cg::grid_group grid = cg::this_grid();
    LAS unsigned char* lds = (LAS unsigned char*)lds_raw;
    const int G = gridDim.x;
    unsigned char* ws = P.ws;
    volatile LAS unsigned* MISC = (volatile LAS unsigned*)(lds + 131072);
    if (threadIdx.x < 16) MISC[threadIdx.x] = 0u;
    __syncthreads();
    const XcdBarrier xbar = xcd_barrier_post((unsigned*)(ws + WS_CTL), MISC + 8);
#define GRID_SYNC() xcd_barrier(xbar)
    bf16_t* XL = (bf16_t*)(ws + WS_H); bf16_t* XC = (bf16_t*)(ws + WS_XC);
    const float* MOD = (const float*)(ws + WS_MOD);
    bf16_t* H = (bf16_t*)P.out; bf16_t* BUF1 = (bf16_t*)(ws + WS_BUF1); bf16_t* ACT = (bf16_t*)(ws + WS_ACT);

    bf16_t* XS = (bf16_t*)(ws + WS_XS); u64* SS = (u64*)(ws + WS_SS);
    prologue_phase(P, lds, G);
    if (G > 65535) grid.sync();
    GRID_SYNC();
    prenorm_phase(P.in[0], P.in[2], P.in[6], MOD + 1 * DM, XS, SS, XL, XC, G);
    shw_phase(ws, lds, blockIdx.x, G, 0, 0, 136); shw_phase(ws, lds, blockIdx.x, G, 1, 0, 356);
    GRID_SYNC();

    for (int L = 0; L < 4; ++L) {
        const int kind = L % 3, j = L / 3; const bool latonly = (L == 3);
        const bool latout = (L >= 2);
        const bf16_t* srcL = XL; const bf16_t* srcC = XC;
        const float* modL = MOD + (size_t)L * 9 * NMOD;
        const u64* ssA = SS + (size_t)(2 * L) * T; const u64* ssB = SS + (size_t)(2 * L + 1) * T;
        const float* shwI = (const float*)(ws + WS_SHWI) + (size_t)L * 9 * 3072; const float* shwU = (const float*)(ws + WS_SHWU) + (size_t)L * 9 * 5632;
        const bf16_t* Wout;
        if (kind == 0) {
            { pg8::Gemm g{XS, (const bf16_t*)(ws + WS_WCI + j * SZ_WCI), DM, DM}; pg8::Sched S; S.init(latonly, 3072, G, blockIdx.x);
              pg8::Epi<pg8::EK_CONVIN> E{}; E.O = BUF1; E.ldc = 2048; E.ss = ssA; E.shw = shwI; E.shwN = 3072;
              pg8::gemm_phase(lds, g, S, E); }
            GRID_SYNC();
            conv_phase(BUF1, P.in[12] + (size_t)j * 3 * DM, H, latonly, G);
            GRID_SYNC();
            Wout = (const bf16_t*)(ws + WS_WCO + j * SZ_WSQ);
        } else if (kind == 1) {
            { pg8::Gemm g{XS, (const bf16_t*)(ws + WS_WQKV), DM, DM}; pg8::Sched S; S.init(0, 1536, G, blockIdx.x);
              pg8::Epi<pg8::EK_QKV> E{}; E.O = BUF1; E.ldc = 1536; E.ss = ssA; E.shw = shwI; E.shwN = 1536; E.g1 = P.in[17]; E.g2 = P.in[18];
              E.cosT = (const float*)(ws + WS_RGC); E.sinT = (const float*)(ws + WS_RGS); E.xlds = lds + 131072 + 4096;
              pg8::gemm_phase(lds, g, S, E); }
            GRID_SYNC();
            attn_phase<128, 1536, 1536, 2>(BUF1, 128, BUF1 + 1024, BUF1 + 1280, 128, 4, BUF1, H, (char*)lds_raw, G, 576);
            GRID_SYNC();
            Wout = (const bf16_t*)(ws + WS_WGO);
        } else {
            bf16_t* QM = (bf16_t*)(ws + WS_ACT);
            bf16_t* CQ = QM + (size_t)T * 1536; bf16_t* CKV = CQ + (size_t)T * 768; bf16_t* KPE = (bf16_t*)(ws + WS_KPE);
            u64* SSQ = SS + (size_t)8 * T; u64* SSKV = SS + (size_t)9 * T;
            { pg8::Gemm g{XS, (const bf16_t*)(ws + WS_WD), DM, DM}; pg8::Sched S; S.init(0, 1280, G, blockIdx.x);
              pg8::Epi<pg8::EK_MLAD> E{}; E.O = CQ; E.O2 = CKV; E.O3 = KPE; E.g1 = P.in[21]; E.g2 = P.in[24]; E.ssa = SSQ; E.ssb = SSKV;
              E.cosT = (const float*)(ws + WS_RMC); E.sinT = (const float*)(ws + WS_RMS); E.ss = ssA; E.shw = shwI; E.shwN = 1280;
              pg8::gemm_phase(lds, g, S, E); }
            GRID_SYNC();
            { pg8::Gemm g{CQ, (const bf16_t*)(ws + WS_WUQ), 768, 768}; pg8::Sched S; S.init(1, 1536, G, blockIdx.x, 768);
              pg8::Epi<pg8::EK_MLAQ> E{}; E.O = QM; E.ldc = 1536; E.cosT = (const float*)(ws + WS_RMC); E.sinT = (const float*)(ws + WS_RMS); E.ss = SSQ; E.inv_n = 1.f / 768.f;
              pg8::gemm_phase(lds, g, S, E); }
            { pg8::Gemm g{CKV, (const bf16_t*)(ws + WS_WUKV), 256, 256}; pg8::Sched S; S.init(0, 2048, G, blockIdx.x, 256, 1);
              pg8::Epi<pg8::EK_BF16> E{}; E.O = BUF1; E.ldc = 2048; E.ss = SSKV; E.inv_n = 1.f / 256.f;
              pg8::gemm_phase(lds, g, S, E); }
            GRID_SYNC();
            attn_phase<192, 1536, 2048, 1>(QM, 192, BUF1, BUF1 + 128, 256, 1, KPE, H, (char*)lds_raw, G, 512);
            GRID_SYNC();
            Wout = (const bf16_t*)(ws + WS_WMO);
        }
        const bool splitk = !latout && G == 256;
        { pg8::Gemm g{H, Wout, DM, DM};
          pg8::Epi<pg8::EK_RESID> E{}; E.srcL = srcL; E.srcC = srcC; E.dstL = XL; E.dstC = XC; E.gate = modL + 2 * DM; E.slab = (float*)BUF1;
          E.gnext = P.in[7] + L * DM; E.scnext = modL + 4 * DM; E.ssnext = SS + (size_t)(2 * L + 1) * T; E.XS = XS;
          pg8::Sched S; S.init(latout, DM, G, blockIdx.x, DM, 0, splitk); pg8::gemm_phase(lds, g, S, E); }
        GRID_SYNC();
        if (splitk) {
            ctxfix_phase(srcC, XC, (const float*)BUF1, modL + 2 * DM, P.in[7] + L * DM, modL + 4 * DM, XS, SS + (size_t)(2 * L + 1) * T, G);
            GRID_SYNC();
        }
        { pg8::Gemm g{XS, (const bf16_t*)(ws + WS_WUP + L * SZ_WUP), DM, DM}; pg8::Sched S; S.init(latout, 2 * FF, G, blockIdx.x);
          pg8::Epi<pg8::EK_SWIGLU> E{}; E.O = ACT; E.ldc = FF; E.ss = ssB; E.shw = shwU; E.shwN = 5632;
          pg8::gemm_phase(lds, g, S, E); }
        GRID_SYNC();
        { pg8::Gemm g{ACT, (const bf16_t*)(ws + WS_WDN + L * SZ_WDN), FF, FF};
          pg8::Epi<pg8::EK_RESID> E{}; E.srcL = XL; E.srcC = XC; E.dstL = XL; E.dstC = XC; E.gate = modL + 5 * DM; E.slab = (float*)BUF1;
          if (L < 3) { E.gnext = P.in[6] + (L + 1) * DM; E.scnext = MOD + (size_t)(L + 1) * 9 * NMOD + 1 * DM; E.ssnext = SS + (size_t)(2 * L + 2) * T; E.XS = XS; }
          pg8::Sched S; S.init(latout, DM, G, blockIdx.x, FF, 0, splitk); pg8::gemm_phase(lds, g, S, E); }
        GRID_SYNC();
        if (splitk) {
            ctxfix_phase(XC, XC, (const float*)BUF1, modL + 5 * DM, P.in[6] + (L + 1) * DM, MOD + (size_t)(L + 1) * 9 * NMOD + 1 * DM, XS, SS + (size_t)(2 * L + 2) * T, G);
            GRID_SYNC();
        }
    }
    const int ftid = otid(), lane = ftid & 63, gw = blockIdx.x * NWAVES + (ftid >> 6), NGW = G * NWAVES;
    for (int r = gw; r < NB * SEQ; r += 2 * NGW) {
        const int r2 = r + NGW; const bool has2 = r2 < NB * SEQ;
        const bf16_t* xr = XL + (size_t)r * DM; const bf16_t* xr2 = XL + (size_t)(has2 ? r2 : r) * DM; f32x4 v[4], v2[4]; float ss = 0.f, ss2 = 0.f;
#pragma unroll
        for (int q = 0; q < 4; ++q) { const u32x2 t = ((const u32x2*)xr)[lane + 64 * q], t2 = ((const u32x2*)xr2)[lane + 64 * q];
            v[q] = (f32x4){bflo(t.x), bfhi(t.x), bflo(t.y), bfhi(t.y)}; v2[q] = (f32x4){bflo(t2.x), bfhi(t2.x), bflo(t2.y), bfhi(t2.y)}; }
#pragma unroll
        for (int q = 0; q < 4; ++q) { ss += (v[q].x * v[q].x + v[q].y * v[q].y) + (v[q].z * v[q].z + v[q].w * v[q].w); ss2 += (v2[q].x * v2[q].x + v2[q].y * v2[q].y) + (v2[q].z * v2[q].z + v2[q].w * v2[q].w); }
#pragma unroll
        for (int o = 1; o < 64; o <<= 1) { ss += __shfl_xor(ss, o); ss2 += __shfl_xor(ss2, o); }
        const float rstd = 1.0f / sqrtf(ss * (1.f / DM) + EPS), rstd2 = 1.0f / sqrtf(ss2 * (1.f / DM) + EPS);
        float* orow = P.out + (size_t)r * DM; float* orow2 = P.out + (size_t)(has2 ? r2 : r) * DM;
#pragma unroll
        for (int q = 0; q < 4; ++q) { const f32x4 gv = ((const f32x4*)P.in[27])[lane + 64 * q]; ((f32x4*)orow)[lane + 64 * q] = v[q] * rstd * gv; if (has2) ((f32x4*)orow2)[lane + 64 * q] = v2[q] * rstd2 * gv; }
    }
}

extern "C" void kernel_launch(void* const* d_in, const int* in_sizes, int n_in, void* d_out, int out_size, void* d_ws, size_t ws_size, hipStream_t stream) {
    static int grid = 0;
    if (grid == 0) {
        if (n_in != 28 || in_sizes[0] != NB * SEQ * DM || out_size != NB * SEQ * DM || ws_size < WS_END) {
            fprintf(stderr, "kernel_launch: shape/workspace mismatch: n_in %d in0 %d out %d ws %zu (need %zu)\n", n_in, n_in > 0 ? in_sizes[0] : -1, out_size, ws_size, (size_t)WS_END); grid = -1; return; }
        int dev = 0, cus = 0, per_cu = 0;
        if (hipGetDevice(&dev) != hipSuccess || hipDeviceGetAttribute(&cus, hipDeviceAttributeMultiprocessorCount, dev) != hipSuccess) { grid = -1; return; }
        if (hipFuncSetAttribute((const void*)fwd_megakernel, hipFuncAttributeMaxDynamicSharedMemorySize, LDS_BYTES) != hipSuccess) { fprintf(stderr, "kernel_launch: hipFuncSetAttribute failed\n"); grid = -1; return; }
        if (hipOccupancyMaxActiveBlocksPerMultiprocessor(&per_cu, (const void*)fwd_megakernel, NTHREADS, LDS_BYTES) != hipSuccess || per_cu < 1) { fprintf(stderr, "kernel_launch: occupancy query says %d\n", per_cu); per_cu = 1; }
        (void)hipGetLastError();
        grid = cus;
    }
    if (grid < 0) return;
    Params p{};
    for (int i = 0; i < 28; ++i) p.in[i] = (const float*)d_in[i];
    p.out = (float*)d_out; p.ws = (unsigned char*)d_ws;
    if (hipMemsetAsync((char*)d_ws + WS_CTL, 0, CTL_BYTES, stream) != hipSuccess) { fprintf(stderr, "kernel_launch: memset failed\n"); return; }
    void* args[] = {&p};
    hipError_t e = hipLaunchCooperativeKernel((const void*)fwd_megakernel, dim3(grid), dim3(NTHREADS), args, LDS_BYTES, stream);
    if (e != hipSuccess) fprintf(stderr, "kernel_launch: cooperative launch failed: %s (grid %d)\n", hipGetErrorString(e), grid);
}
```
